# Optimizing an MI355X kernel written in HIP

```python
import math
import jax, jax.numpy as jnp
from jax import lax
import numpy as np

D_MODEL = 1024
BATCH = 8
SEQ = 4096
DEPTH = 2

CHUNK = 64
Q_BLOCK = 128
HEAD_DIM = 64
RMS_EPS = 1e-6
A_HEADS = 4
A_V_DIM = 2 * HEAD_DIM
B_HEADS = 8
IDX_HEADS = 4
IDX_DIM = HEAD_DIM
TOPK_MAX = 256
C_HEADS = D_MODEL // HEAD_DIM
C_LEFT_CHUNKS = 8
C_BAND = (C_LEFT_CHUNKS + 1) * CHUNK
C_REL_CLIP = 128
T5_BUCKETS = 32
T5_MAX_DIST = 1024
T5_HEADS = A_HEADS + B_HEADS
N_GROUPS = 4
EXPERTS_PER_GROUP = 8
N_EXPERTS = N_GROUPS * EXPERTS_PER_GROUP
EXPERT_TOPK = 2
D_EXPERT = D_MODEL // 2
N_EVEN = (DEPTH + 1) // 2
N_ODD = DEPTH // 2
AB_WIDTHS = (A_HEADS * 2 * HEAD_DIM, A_HEADS * 2 * HEAD_DIM, A_HEADS * A_V_DIM,
             B_HEADS * HEAD_DIM, HEAD_DIM, HEAD_DIM, IDX_HEADS * IDX_DIM, IDX_DIM, IDX_HEADS)
AB_SPLITS = tuple(sum(AB_WIDTHS[:i + 1]) for i in range(len(AB_WIDTHS) - 1))
AB_IN = sum(AB_WIDTHS)
AB_OUT = A_HEADS * A_V_DIM + B_HEADS * HEAD_DIM
NEG = -1e30

kernel_name = "hybrid_chunk_causal_diff_dsa_band_hmoe"


def rms_norm(x, g):
    xf = x.astype(jnp.float32)
    y = xf * lax.rsqrt(jnp.mean(xf * xf, axis=-1, keepdims=True) + RMS_EPS)
    return (y * g.astype(jnp.float32)).astype(x.dtype)


def masked_softmax(s, mask):
    return jax.nn.softmax(jnp.where(mask, s.astype(jnp.float32), NEG), axis=-1)


def t5_bucket(rel):
    half = T5_BUCKETS // 2
    max_exact = half // 2
    ret = jnp.where(rel > 0, half, 0)
    n = jnp.abs(rel)
    nf = jnp.maximum(n, 1).astype(jnp.float32)
    large = max_exact + (jnp.log(nf / max_exact) / math.log(T5_MAX_DIST / max_exact)
                         * (half - max_exact)).astype(jnp.int32)
    large = jnp.minimum(large, half - 1)
    return (ret + jnp.where(n < max_exact, n, large)).astype(jnp.int32)


def diff_sparse_mixer(xn, w_in, w_out, lam, subln, t5_bias, layer_idx):
    bsz, s_len, _ = xn.shape
    proj = xn @ w_in
    q_a, k_a, v_a, q_b, k_b, v_b, q_i, k_i, w_i = jnp.split(proj, AB_SPLITS, axis=-1)
    q_a = q_a.reshape(bsz, s_len, A_HEADS, 2, HEAD_DIM)
    k_a = k_a.reshape(bsz, s_len, A_HEADS, 2, HEAD_DIM)
    v_a = v_a.reshape(bsz, s_len, A_HEADS, A_V_DIM)
    q_b = q_b.reshape(bsz, s_len, B_HEADS, HEAD_DIM)
    q_i = q_i.reshape(bsz, s_len, IDX_HEADS, IDX_DIM)
    w_i = w_i.astype(jnp.float32) * (IDX_HEADS ** -0.5) * (IDX_DIM ** -0.5)

    lam_init = 0.8 - 0.6 * math.exp(-0.3 * layer_idx)
    lamf = lam.astype(jnp.float32)
    lam_full = jnp.exp(jnp.sum(lamf[0] * lamf[1])) - jnp.exp(jnp.sum(lamf[2] * lamf[3])) + lam_init

    top_k = min(TOPK_MAX, s_len // 4)
    scale = HEAD_DIM ** -0.5
    key_pos = jnp.arange(s_len, dtype=jnp.int32)
    key_chunk = key_pos // CHUNK
    t5_a = t5_bias[:, :A_HEADS]
    t5_b = t5_bias[:, A_HEADS:]
    gather_rows = jax.vmap(lambda arr, idx: arr[idx])

    def block(i):
        start = i * Q_BLOCK
        qpos = start + jnp.arange(Q_BLOCK, dtype=jnp.int32)
        qchunk = qpos // CHUNK
        mask = key_chunk[None, :] <= qchunk[:, None]
        qa = lax.dynamic_slice_in_dim(q_a, start, Q_BLOCK, axis=1)
        bias_a = t5_a[t5_bucket(key_pos[None, :] - qpos[:, None])].transpose(2, 0, 1)
        s_a = jnp.einsum('bqhmd,bshmd->bhmqs', qa, k_a) * scale + bias_a[None, :, None]
        p_a = masked_softmax(s_a, mask[None, None, None])
        attn_a = (p_a[:, :, 0] - lam_full * p_a[:, :, 1]).astype(v_a.dtype)
        out_a = jnp.einsum('bhqs,bshe->bqhe', attn_a, v_a)
        out_a = rms_norm(out_a, subln) * (1.0 - lam_init)
        out_a = out_a.reshape(bsz, Q_BLOCK, A_HEADS * A_V_DIM)
        qi = lax.dynamic_slice_in_dim(q_i, start, Q_BLOCK, axis=1)
        wi = lax.dynamic_slice_in_dim(w_i, start, Q_BLOCK, axis=1)
        isc = jax.nn.relu(jnp.einsum('bqhd,bsd->bqhs', qi, k_i).astype(jnp.float32))
        isc = jnp.einsum('bqhs,bqh->bqs', isc, wi)
        isc = jnp.where(mask[None], isc, -jnp.inf)
        _, sel = lax.top_k(isc, top_k)
        sel_valid = (sel // CHUNK) <= qchunk[None, :, None]
        k_sel = gather_rows(k_b, sel)
        v_sel = gather_rows(v_b, sel)
        qb = lax.dynamic_slice_in_dim(q_b, start, Q_BLOCK, axis=1)
        bias_b = t5_b[t5_bucket(sel - qpos[None, :, None])].transpose(0, 3, 1, 2)
        s_b = jnp.einsum('bqhd,bqkd->bhqk', qb, k_sel) * scale + bias_b
        p_b = masked_softmax(s_b, sel_valid[:, None]).astype(v_sel.dtype)
        out_b = jnp.einsum('bhqk,bqkd->bqhd', p_b, v_sel).reshape(bsz, Q_BLOCK, B_HEADS * HEAD_DIM)
        return jnp.concatenate([out_a, out_b], axis=-1)

    outs = lax.map(block, jnp.arange(s_len // Q_BLOCK))
    y = outs.transpose(1, 0, 2, 3).reshape(bsz, s_len, AB_OUT)
    return y @ w_out


def chunk_band_mixer(xn, w_in, w_out, rel_table):
    bsz, s_len, _ = xn.shape
    q, k, v = jnp.split(xn @ w_in, 3, axis=-1)
    q = q.reshape(bsz, s_len, C_HEADS, HEAD_DIM)
    k = k.reshape(bsz, s_len, C_HEADS, HEAD_DIM)
    v = v.reshape(bsz, s_len, C_HEADS, HEAD_DIM)
    pad = C_LEFT_CHUNKS * CHUNK
    k_pad = jnp.pad(k, ((0, 0), (pad, 0), (0, 0), (0, 0)))
    v_pad = jnp.pad(v, ((0, 0), (pad, 0), (0, 0), (0, 0)))
    qi = jnp.arange(CHUNK, dtype=jnp.int32)
    kj = jnp.arange(C_BAND, dtype=jnp.int32)
    rel = qi[:, None] - (kj[None, :] - pad)
    rel_idx = jnp.clip(rel, -C_REL_CLIP, C_REL_CLIP) + C_REL_CLIP
    bias = rel_table[rel_idx].transpose(2, 0, 1)
    scale = HEAD_DIM ** -0.5

    def chunk(c):
        start = c * CHUNK
        qc = lax.dynamic_slice_in_dim(q, start, CHUNK, axis=1)
        kc = lax.dynamic_slice_in_dim(k_pad, start, C_BAND, axis=1)
        vc = lax.dynamic_slice_in_dim(v_pad, start, C_BAND, axis=1)
        valid = (start - pad + kj) >= 0
        s = jnp.einsum('bqhd,bkhd->bhqk', qc, kc) * scale + bias[None]
        p = masked_softmax(s, valid[None, None, None, :]).astype(vc.dtype)
        return jnp.einsum('bhqk,bkhd->bqhd', p, vc)

    outs = lax.map(chunk, jnp.arange(s_len // CHUNK))
    y = outs.transpose(1, 0, 2, 3, 4).reshape(bsz, s_len, C_HEADS * HEAD_DIM)
    return y @ w_out


def hier_moe(xn, w_rg, b_rg, w_re, b_re, w_gate, w_up, w_down):
    bsz, s_len, d = xn.shape
    xt = xn.reshape(-1, d)
    n_tok = xt.shape[0]
    g_logits = (xt @ w_rg + b_rg).astype(jnp.float32)
    p_g = jax.nn.softmax(g_logits, axis=-1)
    g_sel = jnp.argmax(g_logits, axis=-1)
    p_gsel = jnp.take_along_axis(p_g, g_sel[:, None], axis=1)
    e_logits = (xt @ w_re + b_re).astype(jnp.float32).reshape(n_tok, N_GROUPS, EXPERTS_PER_GROUP)
    e_logits = jnp.take_along_axis(e_logits, g_sel[:, None, None], axis=1)[:, 0]
    p_e = jax.nn.softmax(e_logits, axis=-1)
    top_w, top_i = lax.top_k(p_e, EXPERT_TOPK)
    top_w = top_w / jnp.sum(top_w, axis=-1, keepdims=True)
    w_within = jnp.sum(jax.nn.one_hot(top_i, EXPERTS_PER_GROUP, dtype=jnp.float32) * top_w[..., None], axis=1)
    combine = (jax.nn.one_hot(g_sel, N_GROUPS, dtype=jnp.float32)[:, :, None]
               * w_within[:, None, :]).reshape(n_tok, N_EXPERTS) * p_gsel
    combine = combine.astype(xt.dtype)
    y = jnp.zeros_like(xt)
    for e in range(N_EXPERTS):
        h = jax.nn.silu(xt @ w_gate[e]) * (xt @ w_up[e])
        y = y + combine[:, e:e + 1] * (h @ w_down[e])
    return y.reshape(bsz, s_len, d)


def setup_inputs(seed: int = 0) -> dict:
    key = jax.random.key(seed)
    ks = jax.random.split(key, 20)
    f32 = jnp.float32

    def nrm(k, shape, fan_in):
        return jax.random.normal(k, shape, f32) * (fan_in ** -0.5)

    def gain(k, shape):
        return 1.0 + 0.02 * jax.random.normal(k, shape, f32)

    return {
        "x": jax.random.normal(ks[0], (BATCH, SEQ, D_MODEL), f32),
        "t5_bias": 0.2 * jax.random.normal(ks[1], (T5_BUCKETS, T5_HEADS), f32),
        "ln_mix": gain(ks[2], (DEPTH, D_MODEL)),
        "ln_ffn": gain(ks[3], (DEPTH, D_MODEL)),
        "ln_final": gain(ks[4], (D_MODEL,)),
        "ab_w_in": nrm(ks[5], (N_EVEN, D_MODEL, AB_IN), D_MODEL),
        "ab_w_out": nrm(ks[6], (N_EVEN, AB_OUT, D_MODEL), AB_OUT),
        "diff_lambda": 0.1 * jax.random.normal(ks[7], (N_EVEN, 4, HEAD_DIM), f32),
        "diff_subln": gain(ks[8], (N_EVEN, A_V_DIM)),
        "c_w_in": nrm(ks[9], (N_ODD, D_MODEL, 3 * C_HEADS * HEAD_DIM), D_MODEL),
        "c_w_out": nrm(ks[10], (N_ODD, C_HEADS * HEAD_DIM, D_MODEL), C_HEADS * HEAD_DIM),
        "c_rel_bias": 0.2 * jax.random.normal(ks[11], (N_ODD, 2 * C_REL_CLIP + 1, C_HEADS), f32),
        "moe_w_rg": nrm(ks[12], (DEPTH, D_MODEL, N_GROUPS), D_MODEL),
        "moe_b_rg": 0.01 * jax.random.normal(ks[13], (DEPTH, N_GROUPS), f32),
        "moe_w_re": nrm(ks[14], (DEPTH, D_MODEL, N_EXPERTS), D_MODEL),
        "moe_b_re": 0.01 * jax.random.normal(ks[15], (DEPTH, N_EXPERTS), f32),
        "moe_w_gate": nrm(ks[16], (DEPTH, N_EXPERTS, D_MODEL, D_EXPERT), D_MODEL),
        "moe_w_up": nrm(ks[17], (DEPTH, N_EXPERTS, D_MODEL, D_EXPERT), D_MODEL),
        "moe_w_down": nrm(ks[18], (DEPTH, N_EXPERTS, D_EXPERT, D_MODEL), D_EXPERT),
    }


def reference(x, t5_bias, ln_mix, ln_ffn, ln_final, ab_w_in, ab_w_out, diff_lambda, diff_subln,
              c_w_in, c_w_out, c_rel_bias, moe_w_rg, moe_b_rg, moe_w_re, moe_b_re,
              moe_w_gate, moe_w_up, moe_w_down):
    h = x
    for l in range(DEPTH):
        xn = rms_norm(h, ln_mix[l])
        if l % 2 == 0:
            e = l // 2
            h = h + diff_sparse_mixer(xn, ab_w_in[e], ab_w_out[e], diff_lambda[e], diff_subln[e], t5_bias, l)
        else:
            o = l // 2
            h = h + chunk_band_mixer(xn, c_w_in[o], c_w_out[o], c_rel_bias[o])
        xn = rms_norm(h, ln_ffn[l])
        h = h + hier_moe(xn, moe_w_rg[l], moe_b_rg[l], moe_w_re[l], moe_b_re[l],
                         moe_w_gate[l], moe_w_up[l], moe_w_down[l])
    return rms_norm(h, ln_final)
```

```cpp
#include <hip/hip_runtime.h>
#include <cstdio>
#include <cstdint>

constexpr int D = 1024, BATCH = 8, SEQ = 4096, NTOK = BATCH * SEQ;
constexpr int AB_IN = 2500, AB_INP = 2560, C_IN = 3072;
constexpr int NEXP = 32, DEXP = 512;
constexpr float EPS = 1e-6f;
constexpr float LOG2E = 1.4426950408889634f;
constexpr float QSCALE = 0.125f * LOG2E;
constexpr size_t MiB = 1u << 20;

#define GAS __attribute__((address_space(1)))
#define LAS __attribute__((address_space(3)))
typedef unsigned short bf16_t;
typedef short bf16x8 __attribute__((ext_vector_type(8)));
typedef short s16x4 __attribute__((ext_vector_type(4)));
typedef float f32x2 __attribute__((ext_vector_type(2)));
typedef float f32x4 __attribute__((ext_vector_type(4)));
typedef float f32x16 __attribute__((ext_vector_type(16)));
typedef unsigned u32x2 __attribute__((ext_vector_type(2)));
typedef unsigned u32x4 __attribute__((ext_vector_type(4)));

constexpr size_t WS_CTL = 0, CTL_ZERO_BYTES = 256 * 1024;
constexpr size_t WS_RW = 1 * MiB;
constexpr size_t WS_SSQ = 2 * MiB;
constexpr size_t WS_LIST = 4 * MiB;
constexpr size_t WS_WIN0 = 12 * MiB;
constexpr size_t WS_WOUT0 = 17 * MiB;
constexpr size_t WS_WCIN = 19 * MiB;
constexpr size_t WS_WCOUT = 25 * MiB;
constexpr size_t WS_WGU = 28 * MiB;
constexpr size_t WS_WD = 156 * MiB;
constexpr size_t WS_XN = 220 * MiB;
constexpr size_t WS_BIG = 284 * MiB;
constexpr size_t WS_H = WS_BIG, WS_Y0 = WS_BIG + 72 * MiB, WS_Y1 = WS_Y0 + 64 * MiB;
constexpr size_t WS_END = WS_BIG + 200 * MiB;
static_assert(WS_Y1 + 64 * MiB <= WS_END, "ws map");

constexpr int NWAVES = 8;
constexpr int NPHASE = 15;
constexpr int RING_OFF = 0, RING_BYTES = 131072;
constexpr int TAB_OFF = RING_BYTES, TAB_BYTES = 27648;
constexpr int MISC_OFF = TAB_OFF + TAB_BYTES;
constexpr int LDS_BYTES = MISC_OFF + 1024;
static_assert(LDS_BYTES <= 160 * 1024, "LDS");


constexpr int CW_TMO = 0;
constexpr int CW_CNT = 64;
constexpr int CW_LAM = 192;
constexpr int CW_BAR = 4096;

__device__ __forceinline__ float wave_sum(float v) {
#pragma unroll
    for (int o = 1; o < 64; o <<= 1) v += __shfl_xor(v, o);
    return v;
}
__device__ __forceinline__ float wave_max(float v) {
#pragma unroll
    for (int o = 1; o < 64; o <<= 1) v = fmaxf(v, __shfl_xor(v, o));
    return v;
}
__host__ __device__ __forceinline__ int t5_bucket(int rel) {
    int n = rel < 0 ? -rel : rel;
    int b = n < 8 ? n : (8 + (n >= 15) + (n >= 27) + (n >= 50) + (n >= 91) + (n >= 166) + (n >= 305) + (n >= 559));
    return (rel > 0 ? 16 : 0) + b;
}
__device__ __forceinline__ unsigned cvt_pk_bf16(float lo, float hi) { unsigned r; asm volatile("v_cvt_pk_bf16_f32 %0, %1, %2" : "=v"(r) : "v"(lo), "v"(hi)); return r; }
__device__ __forceinline__ float bf2f(bf16_t b) { return __uint_as_float((unsigned)b << 16); }
__device__ __forceinline__ float bflo(unsigned w) { return __uint_as_float(w << 16); }
__device__ __forceinline__ float bfhi(unsigned w) { return __uint_as_float(w & 0xffff0000u); }
#define LDS_WAIT() asm volatile("s_waitcnt lgkmcnt(0)" ::: "memory")
#define VM_WAIT() asm volatile("s_waitcnt vmcnt(0)" ::: "memory")
namespace pg8 {
constexpr int BM = 256, BK = 64, HALF = 128, HTB = HALF * BK * 2, STAGE_BYTES = 8 * HTB, NXCD = 8, WGM = 8;
__host__ __device__ __forceinline__ int lds_byte(int r, int c) { const int st = (r >> 4) * 2 + (c >> 5), rr = r & 15, cc = c & 31, ob = rr * 64 + cc * 2; return st * 1024 + (ob ^ (((ob >> 9) & 1) << 5)); }
__host__ __device__ __forceinline__ void stage_rc(int b, int& R, int& C) { const int st = b / 1024, sb = b % 1024, swz = sb ^ (((sb >> 9) & 1) << 5); R = (st >> 1) * 16 + swz / 64; C = (st & 1) * 32 + (swz % 64) / 2; }
__host__ __device__ __forceinline__ int perm32(int rho) { const int n = rho >> 4, i = rho & 15; return 8 * (i >> 2) + 4 * n + (i & 3); }

struct Unit { int pm, pn, e, rows, lbase; unsigned aoff; size_t boff; };
struct Gemm { const bf16_t* A; const bf16_t* Bt; int lda, ldb, K; const int* list; };

struct DenseOrder {
    static constexpr bool GATHER = false;
    int nM, nN, nwg, G, c, rep; unsigned astep; size_t bstep;
    __device__ void init(int M, int N, int G_, int c_, int lda, int ldb, int rep_ = 1) { nM = M / BM; nN = N / BM; nwg = nM * nN; G = G_; c = c_; rep = rep_; astep = (unsigned)BM * lda * 2u; bstep = (size_t)BM * ldb * 2; }
    __device__ bool next(int i, Unit& u) const {
        long L = (long)i * G + c; if (L >= (long)nwg * rep) return false;
        if (L >= nwg) L -= nwg;
        int wgid = (int)L; { const int q = nwg / NXCD, r = nwg % NXCD, xcd = wgid % NXCD, off = wgid / NXCD; wgid = (xcd < r ? xcd * (q + 1) : r * (q + 1) + (xcd - r) * q) + off; }
        const int nig = WGM * nN, gid = wgid / nig, fm = gid * WGM, gsz = (nM - fm) < WGM ? (nM - fm) : WGM;
        u.pm = fm + ((wgid % nig) % gsz); u.pn = (wgid % nig) / gsz; u.e = 0; u.rows = BM; u.lbase = 0; u.aoff = (unsigned)u.pm * astep; u.boff = (size_t)u.pn * bstep; return true;
    }
};
template <bool GATH> struct MoeOrder {
    static constexpr bool GATHER = GATH;
    const LAS int* tb; const LAS int* cnt; int G, c, npn, NT; unsigned atile; size_t bexp, bpn; int rep;
    __device__ bool next(int i, Unit& u) const {
        int L = i * G + c; if (L >= NT * npn * rep) return false;
        if (L >= NT * npn) L -= NT * npn;
        const int T = L / npn; u.pn = L - T * npn; u.pm = T;
        int e = 0;
#pragma unroll 1
        for (int j = 1; j < NEXP; ++j) e = (tb[j] <= T) ? j : e;
        e = __builtin_amdgcn_readfirstlane(e);
        const int lt = T - tb[e]; const int r = cnt[e] - 256 * lt;
        u.e = e; u.rows = r < 256 ? r : 256; u.lbase = e * NTOK + 256 * lt; u.aoff = (unsigned)T * atile; u.boff = (size_t)e * bexp + (size_t)u.pn * bpn; return true;
    }
};

struct EpiBf16 {
    bf16_t* O; int ldc;
    __device__ __forceinline__ void operator()(const f32x4 (&acc)[2][2][4][2], const Unit& u, int wr, int wc, int fr, int fq) const {
        const int row0 = u.pm * BM + wr * 64 + fr, col0 = u.pn * BM + wc * 32 + 8 * fq;
#pragma unroll
        for (int ai = 0; ai < 2; ++ai)
#pragma unroll
            for (int m = 0; m < 4; ++m) { bf16_t* rowp = O + (size_t)(row0 + ai * HALF + m * 16) * ldc + col0;
#pragma unroll
                for (int bj = 0; bj < 2; ++bj) { const f32x4 v0 = acc[ai][bj][m][0], v1 = acc[ai][bj][m][1];
                    u32x4 w; w.x = cvt_pk_bf16(v0[0], v0[1]); w.y = cvt_pk_bf16(v0[2], v0[3]); w.z = cvt_pk_bf16(v1[0], v1[1]); w.w = cvt_pk_bf16(v1[2], v1[3]);
                    *(u32x4*)(rowp + bj * HALF) = w; } }
    }
};
template <bool ADDY> struct EpiResid {
    const float* R; float* out; const bf16_t* Y0; const bf16_t* Y1; float* ssq;
    __device__ __forceinline__ void operator()(const f32x4 (&acc)[2][2][4][2], const Unit& u, int wr, int wc, int fr, int fq) const {
        const int row0 = u.pm * BM + wr * 64 + fr, col0 = u.pn * BM + wc * 32 + 8 * fq;
#pragma unroll
        for (int ai = 0; ai < 2; ++ai)
#pragma unroll
            for (int m = 0; m < 4; ++m) { const int row = row0 + ai * HALF + m * 16; const size_t off = (size_t)row * D + col0; float ss = 0.f;
#pragma unroll
                for (int bj = 0; bj < 2; ++bj) {
                    f32x4 v0 = acc[ai][bj][m][0] + *(const f32x4*)(R + off + bj * HALF), v1 = acc[ai][bj][m][1] + *(const f32x4*)(R + off + bj * HALF + 4);
                    if (ADDY) { const u32x4 a = *(const u32x4*)(Y0 + off + bj * HALF), b = *(const u32x4*)(Y1 + off + bj * HALF);
                        v0[0] += bflo(a.x) + bflo(b.x); v0[1] += bfhi(a.x) + bfhi(b.x); v0[2] += bflo(a.y) + bflo(b.y); v0[3] += bfhi(a.y) + bfhi(b.y);
                        v1[0] += bflo(a.z) + bflo(b.z); v1[1] += bfhi(a.z) + bfhi(b.z); v1[2] += bflo(a.w) + bflo(b.w); v1[3] += bfhi(a.w) + bfhi(b.w); }
                    *(f32x4*)(out + off + bj * HALF) = v0; *(f32x4*)(out + off + bj * HALF + 4) = v1;
                    ss += v0[0] * v0[0] + v0[1] * v0[1] + v0[2] * v0[2] + v0[3] * v0[3] + v1[0] * v1[0] + v1[1] * v1[1] + v1[2] * v1[2] + v1[3] * v1[3]; }
                ss += __shfl_xor(ss, 16); ss += __shfl_xor(ss, 32);
                if (fq == 0) ssq[(size_t)row * 16 + u.pn * 4 + wc] = ss; }
    }
};
struct EpiSwiglu {
    bf16_t* H;
    __device__ __forceinline__ void operator()(const f32x4 (&acc)[2][2][4][2], const Unit& u, int wr, int wc, int fr, int fq) const {
        const int row0 = u.pm * BM + wr * 64 + fr, col0 = u.pn * HALF + wc * 32 + 8 * fq;
#pragma unroll
        for (int ai = 0; ai < 2; ++ai)
#pragma unroll
            for (int m = 0; m < 4; ++m) { float o[8];
#pragma unroll
                for (int n = 0; n < 2; ++n)
#pragma unroll
                    for (int j = 0; j < 4; ++j) { const float g = acc[ai][0][m][n][j], up = acc[ai][1][m][n][j];
                        o[n * 4 + j] = g * __builtin_amdgcn_rcpf(1.f + __builtin_amdgcn_exp2f(-g * LOG2E)) * up; }
                u32x4 w; w.x = cvt_pk_bf16(o[0], o[1]); w.y = cvt_pk_bf16(o[2], o[3]); w.z = cvt_pk_bf16(o[4], o[5]); w.w = cvt_pk_bf16(o[6], o[7]);
                *(u32x4*)(H + (size_t)(row0 + ai * HALF + m * 16) * DEXP + col0) = w; }
    }
};
struct EpiScatter {
    bf16_t* Y0; bf16_t* Y1; const int* list; const float* lw;
    __device__ __forceinline__ void operator()(const f32x4 (&acc)[2][2][4][2], const Unit& u, int wr, int wc, int fr, int fq) const {
        const int col0 = u.pn * BM + wc * 32 + 8 * fq;
#pragma unroll
        for (int ai = 0; ai < 2; ++ai)
#pragma unroll
            for (int m = 0; m < 4; ++m) { const int r = ai * HALF + wr * 64 + m * 16 + fr;
                if (r < u.rows) { const int ent = list[u.lbase + r]; const float w = lw[u.lbase + r];
                    bf16_t* rowp = Y0 + (size_t)(ent & 1) * (size_t)(Y1 - Y0) + (size_t)(ent >> 1) * D + col0;
#pragma unroll
                    for (int bj = 0; bj < 2; ++bj) { const f32x4 v0 = acc[ai][bj][m][0] * w, v1 = acc[ai][bj][m][1] * w;
                        u32x4 o; o.x = cvt_pk_bf16(v0[0], v0[1]); o.y = cvt_pk_bf16(v0[2], v0[3]); o.z = cvt_pk_bf16(v1[0], v1[1]); o.w = cvt_pk_bf16(v1[2], v1[3]);
                        *(u32x4*)(rowp + bj * HALF) = o; } }
                asm volatile("" ::: "memory"); }
    }
};

template <class Epi, class Sched, bool ALIGN_EPI = true>
__device__ __forceinline__ void gemm_phase(LAS unsigned char* lds, const Gemm g, const Sched& S, const Epi& E) {
    const int tid = threadIdx.x, wid = __builtin_amdgcn_readfirstlane(tid >> 6), lane = tid & 63, wr = wid >> 2, wc = wid & 3, fr = lane & 15, fq = lane >> 4;
    const int K = g.K, nt = K / BK;
    int R0, C0; stage_rc(tid * 16, R0, C0);
    unsigned voffB[2];
#pragma unroll
    for (int i = 0; i < 2; ++i) { const int R = R0 + 64 * i; const int Rb = (R & ~31) + perm32(R & 31); voffB[i] = (unsigned)(Rb * g.ldb + C0) * 2u; }
    const unsigned rowb = (unsigned)g.lda * 2u, colb = (unsigned)C0 * 2u;
    const unsigned kstep = (unsigned)(BK * 2);
    const size_t hstepB = (size_t)HALF * g.ldb * 2;
    const unsigned ldsw = (unsigned)wid * 1024u;
    const int aoff = lds_byte(wr * 64 + fr, fq * 8), boff = lds_byte(wc * 32 + fr, fq * 8);
    const char* Ab = (const char*)g.A;
#define PG8_SA(b, h) (((b) * 2 + (h)) * HTB)
#define PG8_SB(b, h) ((4 + (b) * 2 + (h)) * HTB)
#define PG8_STAGEB(bufoff, gbase) do { _Pragma("unroll") for (int _i = 0; _i < 2; ++_i) \
        __builtin_amdgcn_global_load_lds((const unsigned*)((const char*)(gbase) + voffB[_i]), (LAS unsigned*)(lds + (bufoff) + ldsw + _i * 8192), 16, 0, 0); } while (0)
#define PG8_STAGEA(bufoff, arr, h, kb) do { _Pragma("unroll") for (int _i = 0; _i < 2; ++_i) \
        __builtin_amdgcn_global_load_lds((const unsigned*)(Ab + (size_t)((arr)[2 * (h) + _i] + (kb))), (LAS unsigned*)(lds + (bufoff) + ldsw + _i * 8192), 16, 0, 0); } while (0)
#define PG8_LDA(dst, b, h) do { _Pragma("unroll") for (int m = 0; m < 4; ++m) _Pragma("unroll") for (int k = 0; k < 2; ++k) dst[m][k] = *(const LAS bf16x8*)(lds + PG8_SA(b, h) + aoff + m * 2048 + k * 1024); } while (0)
#define PG8_LDB(dst, b, h) do { _Pragma("unroll") for (int n = 0; n < 2; ++n) _Pragma("unroll") for (int k = 0; k < 2; ++k) dst[n][k] = *(const LAS bf16x8*)(lds + PG8_SB(b, h) + boff + n * 2048 + k * 1024); } while (0)
#define PG8_MMA(ai, bj, At, Bt) do { __builtin_amdgcn_s_setprio(1); _Pragma("unroll") for (int m = 0; m < 4; ++m) _Pragma("unroll") for (int n = 0; n < 2; ++n) _Pragma("unroll") for (int k = 0; k < 2; ++k) \
        acc[ai][bj][m][n] = __builtin_amdgcn_mfma_f32_16x16x32_bf16(Bt[n][k], At[m][k], acc[ai][bj][m][n], 0, 0, 0); __builtin_amdgcn_s_setprio(0); } while (0)
#define PG8_WAIT_V(n) asm volatile("s_waitcnt vmcnt(" #n ")" ::: "memory")
#define PG8_WAIT_L(n) asm volatile("s_waitcnt lgkmcnt(" #n ")" ::: "memory")
#define PG8_BAR __builtin_amdgcn_s_barrier()
#define PG8_SCHED __builtin_amdgcn_sched_barrier(0)
#define PG8_ROWS(arr, u) do { _Pragma("unroll") for (int _j = 0; _j < 4; ++_j) { \
        if constexpr (Sched::GATHER) { const int _r = R0 + 64 * _j; const int _ent = (_r < (u).rows) ? g.list[(u).lbase + _r] : 0; (arr)[_j] = (unsigned)(_ent >> 1) * rowb + colb; } \
        else (arr)[_j] = (u).aoff + (unsigned)(R0 + 64 * _j) * rowb + colb; } } while (0)
    Unit cur, nxt; int ui = 0;
    if (!S.next(0, cur)) return;
    f32x4 acc[2][2][4][2];
#pragma unroll
    for (int a = 0; a < 2; ++a)
#pragma unroll
        for (int b = 0; b < 2; ++b)
#pragma unroll
            for (int m = 0; m < 4; ++m)
#pragma unroll
                for (int n = 0; n < 2; ++n) acc[a][b][m][n] = (f32x4){0.f, 0.f, 0.f, 0.f};
    bf16x8 At[4][2], B0[2][2], B1[2][2];
    unsigned ca[4], na[4];
    PG8_ROWS(ca, cur);
    const char* cB = (const char*)g.Bt + cur.boff;
    PG8_STAGEB(PG8_SB(0, 0), cB); PG8_STAGEB(PG8_SB(0, 1), cB + hstepB); PG8_STAGEA(PG8_SA(0, 0), ca, 0, 0u); PG8_STAGEA(PG8_SA(0, 1), ca, 1, 0u);
    if (wr == 1) PG8_BAR;
    PG8_WAIT_V(2); PG8_BAR;
    PG8_STAGEB(PG8_SB(1, 0), cB + kstep); PG8_STAGEA(PG8_SA(1, 0), ca, 0, kstep); PG8_STAGEB(PG8_SB(1, 1), cB + hstepB + kstep);
    PG8_WAIT_V(6); PG8_BAR;
    for (;;) {
        const bool has_next = S.next(ui + 1, nxt);
        if (has_next) { PG8_ROWS(na, nxt); } else {
#pragma unroll
            for (int j = 0; j < 4; ++j) na[j] = ca[j]; }
        const char* nB = has_next ? (const char*)g.Bt + nxt.boff : cB;
        for (int t = 0; t < nt; t += 2) {
            const bool last = (t == nt - 2);
            const unsigned k1 = (unsigned)(t + 1) * kstep;
            const unsigned k2 = last ? 0u : (unsigned)(t + 2) * kstep, k3 = k2 + kstep;
            unsigned a2[4];
#pragma unroll
            for (int j = 0; j < 4; ++j) a2[j] = last ? na[j] : ca[j];
            const char* b2 = (last ? nB : cB) + k2; const char* b3 = b2 + kstep;
            PG8_LDB(B0, 0, 0); PG8_LDB(B1, 0, 1); PG8_SCHED; PG8_LDA(At, 0, 0); PG8_STAGEA(PG8_SA(1, 1), ca, 1, k1);
            PG8_WAIT_V(8); PG8_WAIT_L(0); PG8_BAR; PG8_MMA(0, 0, At, B0); PG8_MMA(0, 1, At, B1); PG8_BAR; PG8_SCHED;
            PG8_LDA(At, 0, 1); PG8_STAGEB(PG8_SB(0, 0), b2); PG8_STAGEB(PG8_SB(0, 1), b2 + hstepB); PG8_STAGEA(PG8_SA(0, 0), a2, 0, k2);
            PG8_WAIT_V(8); PG8_WAIT_L(0); PG8_BAR; PG8_MMA(1, 0, At, B0); PG8_MMA(1, 1, At, B1); PG8_BAR; PG8_SCHED;
            PG8_LDB(B0, 1, 0); PG8_LDB(B1, 1, 1); PG8_SCHED; PG8_LDA(At, 1, 0); PG8_STAGEA(PG8_SA(0, 1), a2, 1, k2);
            PG8_WAIT_V(8); PG8_WAIT_L(0); PG8_BAR; PG8_MMA(0, 0, At, B0); PG8_MMA(0, 1, At, B1); PG8_BAR; PG8_SCHED;
            PG8_LDA(At, 1, 1); PG8_STAGEB(PG8_SB(1, 0), b3); PG8_STAGEB(PG8_SB(1, 1), b3 + hstepB); PG8_STAGEA(PG8_SA(1, 0), a2, 0, k3);
            PG8_WAIT_V(8); PG8_WAIT_L(0); PG8_BAR; PG8_MMA(1, 0, At, B0); PG8_MMA(1, 1, At, B1); PG8_BAR; PG8_SCHED;
        }
        if constexpr (ALIGN_EPI) { if (wr == 0) PG8_BAR; }
        E(acc, cur, wr, wc, fr, fq);
        if (!has_next) break;
#pragma unroll
        for (int a = 0; a < 2; ++a)
#pragma unroll
            for (int b = 0; b < 2; ++b)
#pragma unroll
                for (int m = 0; m < 4; ++m)
#pragma unroll
                    for (int n = 0; n < 2; ++n) acc[a][b][m][n] = (f32x4){0.f, 0.f, 0.f, 0.f};
        cur = nxt; cB = nB; ++ui;
#pragma unroll
        for (int j = 0; j < 4; ++j) ca[j] = na[j];
        if constexpr (ALIGN_EPI) { if (wr == 1) PG8_BAR; }
    }
    PG8_WAIT_V(0);
    if constexpr (!ALIGN_EPI) { if (wr == 0) PG8_BAR; }
    PG8_BAR;
#undef PG8_SA
#undef PG8_SB
#undef PG8_STAGEA
#undef PG8_STAGEB
#undef PG8_LDA
#undef PG8_LDB
#undef PG8_MMA
#undef PG8_WAIT_V
#undef PG8_WAIT_L
#undef PG8_BAR
#undef PG8_SCHED
#undef PG8_ROWS
}
}
#define XB_TMO      128
#define XB_XCNT(j)  (256  + 64 * (j))
#define XB_XSUB(j)  (1280 + 64 * (j))
#define XB_XGEN(j)  (2304 + 64 * (j))
#define XB_TOP      3328
#define XB_TOPGEN   3392
#define XCD_BAR_WORDS 3456
#define XB_SPIN_CAP (1u << 18)

__device__ __forceinline__ unsigned xb_ld(unsigned* p)              { return __hip_atomic_load(p, __ATOMIC_RELAXED, __HIP_MEMORY_SCOPE_AGENT); }
__device__ __forceinline__ unsigned xb_add(unsigned* p, unsigned v) { return __hip_atomic_fetch_add(p, v, __ATOMIC_RELAXED, __HIP_MEMORY_SCOPE_AGENT); }
__device__ __forceinline__ unsigned xb_xcc_id() { return (unsigned)__builtin_amdgcn_s_getreg((3 << 11) | 20) & 0xFu; }
#define XB_SPIN(cond, bar) do { unsigned _sp = 0; while (cond) { __builtin_amdgcn_s_sleep(1); \
    if ((++_sp & 255u) == 0u) { if (xb_ld(&(bar)[XB_TMO])) break; if (_sp > XB_SPIN_CAP) { atomicAdd(&(bar)[XB_TMO], 1u); break; } } } } while (0)

struct XcdBarrier {
    unsigned* bar; unsigned x;
    volatile LAS unsigned* st;
};

__device__ __forceinline__ XcdBarrier xcd_barrier_post(unsigned* bar, volatile LAS unsigned* st) {
    XcdBarrier b; b.bar = bar; b.x = xb_xcc_id(); b.st = st;
    if (threadIdx.x == 0) (void)xb_add(&bar[XB_XCNT(b.x)], 1u);
    return b;
}
__device__ __forceinline__ void xcd_barrier_complete(unsigned* bar, unsigned x, unsigned& nloc, unsigned& nx) {
    const unsigned G = gridDim.x * gridDim.y * gridDim.z;
    unsigned sum, cnt, mine, sp = 0u;
    for (;;) {
        sum = 0u; cnt = 0u; mine = 0u;
#pragma unroll
        for (unsigned j = 0; j < 16; ++j) { const unsigned c = xb_ld(&bar[XB_XCNT(j)]); sum += c; cnt += (c > 0u) ? 1u : 0u; mine = (j == x) ? c : mine; }
        if (sum == G) break;
        __builtin_amdgcn_s_sleep(1);
        if ((++sp & 255u) == 0u) { if (xb_ld(&bar[XB_TMO])) break; if (sp > XB_SPIN_CAP) { atomicAdd(&bar[XB_TMO], 1u); break; } }
    }
    nloc = mine > 0u ? mine : 1u; nx = cnt > 0u ? cnt : 1u;
}

__device__ __forceinline__ void xcd_barrier(const XcdBarrier& b) {
    asm volatile("s_waitcnt vmcnt(0)" ::: "memory");
    __syncthreads();
    if (threadIdx.x == 0) {
        unsigned* bar = b.bar;
        __builtin_amdgcn_s_waitcnt(0);
        unsigned nloc = b.st[0], nx = b.st[1];
        if (nloc == 0u) { xcd_barrier_complete(bar, b.x, nloc, nx); b.st[0] = nloc; b.st[1] = nx; }
        const unsigned old = xb_add(&bar[XB_XSUB(b.x)], 1u);
        const unsigned gen = old / nloc;
        if (old + 1u == (gen + 1u) * nloc) {
            __builtin_amdgcn_fence(__ATOMIC_RELEASE, "agent");
            asm volatile("s_waitcnt vmcnt(0)" ::: "memory");
            const unsigned og = xb_add(&bar[XB_TOP], 1u);
            const unsigned tg = og / nx;
            if (og + 1u == (tg + 1u) * nx) xb_add(&bar[XB_TOPGEN], 1u);
            else XB_SPIN(xb_ld(&bar[XB_TOPGEN]) == tg, bar);
            __builtin_amdgcn_fence(__ATOMIC_ACQUIRE, "agent");
            xb_add(&bar[XB_XGEN(b.x)], 1u);
            asm volatile("s_waitcnt vmcnt(0)" ::: "memory");
        } else {
            XB_SPIN(xb_ld(&bar[XB_XGEN(b.x)]) == gen, bar);
            __builtin_amdgcn_fence(__ATOMIC_ACQUIRE, "agent");
            asm volatile("s_waitcnt vmcnt(0)" ::: "memory");
        }
    }
    __syncthreads();
}
__device__ __forceinline__ unsigned f2bf(float f) { unsigned u = __builtin_bit_cast(unsigned, f); return (u + 0x7fffu + ((u >> 16) & 1u)) >> 16; }
__device__ __forceinline__ unsigned pk2(float lo, float hi) { return f2bf(lo) | (f2bf(hi) << 16); }

__device__ __forceinline__ void conv_item(const float* W, int K, int N, bf16_t* WT, int k0, int n0, int dst_row0, float scale, LAS float* scr, int lane) {
    const int nn = n0 + (lane & 31); const bool ok = nn < N;
    float wv[32];
#pragma unroll
    for (int i = 0; i < 32; ++i) { const int kk = 2 * i + (lane >> 5); wv[i] = ok ? W[(size_t)(k0 + kk) * N + nn] : 0.f; }
#pragma unroll
    for (int i = 0; i < 32; ++i) { const int kk = 2 * i + (lane >> 5); scr[kk * 33 + (lane & 31)] = wv[i] * scale; }
    LDS_WAIT(); asm volatile("" ::: "memory");
    const int c = lane & 7;
#pragma unroll
    for (int j = 0; j < 4; ++j) { const int n = (lane >> 3) + 8 * j; const LAS float* s = scr + (8 * c) * 33 + n;
        u32x4 o; o.x = pk2(s[0 * 33], s[1 * 33]); o.y = pk2(s[2 * 33], s[3 * 33]); o.z = pk2(s[4 * 33], s[5 * 33]); o.w = pk2(s[6 * 33], s[7 * 33]);
        *(GAS u32x4*)(WT + (size_t)(dst_row0 + n) * K + k0 + 8 * c) = o; }
    LDS_WAIT(); asm volatile("" ::: "memory");
}

struct RowIO { const float* src; const bf16_t* y0; const bf16_t* y1; const float* gain; bf16_t* xn; float* fout; };
template <bool ADDY, bool WXN, bool WSUM, bool WNORM>
__device__ __forceinline__ void rms_row(const RowIO& io, int row, int lane) {
    const GAS f32x4* xr = (const GAS f32x4*)(io.src + (size_t)row * D) + lane;
    f32x4 v[4]; float s = 0.f;
#pragma unroll
    for (int j = 0; j < 4; ++j) v[j] = xr[64 * j];
    if (ADDY) {
        const GAS u32x2* a = (const GAS u32x2*)(io.y0 + (size_t)row * D) + lane; const GAS u32x2* b = (const GAS u32x2*)(io.y1 + (size_t)row * D) + lane;
#pragma unroll
        for (int j = 0; j < 4; ++j) { const u32x2 ya = a[64 * j], yb = b[64 * j];
            v[j][0] += bflo(ya.x) + bflo(yb.x); v[j][1] += bfhi(ya.x) + bfhi(yb.x); v[j][2] += bflo(ya.y) + bflo(yb.y); v[j][3] += bfhi(ya.y) + bfhi(yb.y); }
    }
#pragma unroll
    for (int j = 0; j < 4; ++j) s += (v[j][0] * v[j][0] + v[j][1] * v[j][1]) + (v[j][2] * v[j][2] + v[j][3] * v[j][3]);
    const float r = __builtin_amdgcn_rsqf(wave_sum(s) * (1.f / D) + EPS);
    const GAS f32x4* gg = (const GAS f32x4*)io.gain + lane;
#pragma unroll
    for (int j = 0; j < 4; ++j) { const f32x4 o = v[j] * r * gg[64 * j];
        if (WSUM) ((GAS f32x4*)(io.fout + (size_t)row * D) + lane)[64 * j] = v[j];
        if (WXN) { u32x2 w; w.x = cvt_pk_bf16(o[0], o[1]); w.y = cvt_pk_bf16(o[2], o[3]); ((GAS u32x2*)(io.xn + (size_t)row * D) + lane)[64 * j] = w; }
        if (WNORM) ((GAS f32x4*)(io.fout + (size_t)row * D) + lane)[64 * j] = o; }
}

template <bool ADDY, bool WXN, bool WSUM, bool WNORM>
__device__ __forceinline__ void rms_row2(const RowIO& io, int row0, int row1, int lane) {
    f32x4 v[2][4]; u32x2 ya[2][4], yb[2][4];
#pragma unroll
    for (int k = 0; k < 2; ++k) { const int row = k ? row1 : row0; const GAS f32x4* xr = (const GAS f32x4*)(io.src + (size_t)row * D) + lane;
#pragma unroll
        for (int j = 0; j < 4; ++j) v[k][j] = xr[64 * j];
        if (ADDY) { const GAS u32x2* a = (const GAS u32x2*)(io.y0 + (size_t)row * D) + lane; const GAS u32x2* b = (const GAS u32x2*)(io.y1 + (size_t)row * D) + lane;
#pragma unroll
            for (int j = 0; j < 4; ++j) { ya[k][j] = a[64 * j]; yb[k][j] = b[64 * j]; } } }
    f32x4 gg[4];
    { const GAS f32x4* gp = (const GAS f32x4*)io.gain + lane;
#pragma unroll
      for (int j = 0; j < 4; ++j) gg[j] = gp[64 * j]; }
#pragma unroll
    for (int k = 0; k < 2; ++k) { const int row = k ? row1 : row0; float s = 0.f;
        if (ADDY) {
#pragma unroll
            for (int j = 0; j < 4; ++j) { v[k][j][0] += bflo(ya[k][j].x) + bflo(yb[k][j].x); v[k][j][1] += bfhi(ya[k][j].x) + bfhi(yb[k][j].x); v[k][j][2] += bflo(ya[k][j].y) + bflo(yb[k][j].y); v[k][j][3] += bfhi(ya[k][j].y) + bfhi(yb[k][j].y); } }
#pragma unroll
        for (int j = 0; j < 4; ++j) s += (v[k][j][0] * v[k][j][0] + v[k][j][1] * v[k][j][1]) + (v[k][j][2] * v[k][j][2] + v[k][j][3] * v[k][j][3]);
        const float r = __builtin_amdgcn_rsqf(wave_sum(s) * (1.f / D) + EPS);
#pragma unroll
        for (int j = 0; j < 4; ++j) { const f32x4 o = v[k][j] * r * gg[j];
            if (WSUM) ((GAS f32x4*)(io.fout + (size_t)row * D) + lane)[64 * j] = v[k][j];
            if (WXN) { u32x2 w; w.x = cvt_pk_bf16(o[0], o[1]); w.y = cvt_pk_bf16(o[2], o[3]); ((GAS u32x2*)(io.xn + (size_t)row * D) + lane)[64 * j] = w; }
            if (WNORM) ((GAS f32x4*)(io.fout + (size_t)row * D) + lane)[64 * j] = o; } }
}
__device__ __forceinline__ void router_phase(LAS unsigned char* lds, volatile LAS unsigned* MISC, const float* hbuf, const float* SSQ, const float* gain, const bf16_t* RWl, const float* brg, const float* bre,
                                             bf16_t* XN, unsigned* gcnt, int* LIST, float* LW, int vcu, int G, int wave, int lane, int tid) {
    LAS float* lg = (LAS float*)(lds + RING_OFF) + wave * (16 * 48);
    volatile LAS unsigned* lcnt = MISC + 64;
    volatile LAS unsigned* lbase = MISC + 96;
    const int tr = lane & 15, g = lane >> 4;
    constexpr int NTILE = NTOK / 16;
    const int rounds = (NTILE + G * NWAVES - 1) / (G * NWAVES);
    __syncthreads(); if (tid < 2 * NEXP) MISC[64 + tid] = 0u; __syncthreads();
    for (int r = 0; r < rounds; ++r) {
        const int tile = (r * G + vcu) * NWAVES + wave;
        const bool act = tile < NTILE;
        int e1 = 0, e2 = 0, p1 = 0, p2 = 0; float w1 = 0.f, w2 = 0.f; int tok = 0;
        if (act) {
            const int t0 = tile * 16; tok = t0 + tr;
            const GAS f32x4* sq = (const GAS f32x4*)(SSQ + (size_t)tok * 16);
            const f32x4 s0 = sq[0], s1 = sq[1], s2 = sq[2], s3 = sq[3];
            const float ss = ((s0[0] + s0[1]) + (s0[2] + s0[3])) + ((s1[0] + s1[1]) + (s1[2] + s1[3])) + ((s2[0] + s2[1]) + (s2[2] + s2[3])) + ((s3[0] + s3[1]) + (s3[2] + s3[3]));
            const float rstd = __builtin_amdgcn_rsqf(ss * (1.f / D) + EPS);
            f32x4 acc[3] = {(f32x4){0.f, 0.f, 0.f, 0.f}, (f32x4){0.f, 0.f, 0.f, 0.f}, (f32x4){0.f, 0.f, 0.f, 0.f}};
            const float* hrow = hbuf + (size_t)tok * D + 8 * g;
            const float* grow = gain + 8 * g;
            bf16_t* xrow = XN + (size_t)tok * D + 8 * g;
            const bf16_t* whi = RWl + (size_t)tr * D + 8 * g;
            const bf16_t* wlo = RWl + (size_t)48 * D + (size_t)tr * D + 8 * g;
#pragma unroll 4
            for (int ks = 0; ks < 32; ++ks) {
                const f32x4 h0 = *(const GAS f32x4*)(hrow + 32 * ks), h1 = *(const GAS f32x4*)(hrow + 32 * ks + 4);
                const f32x4 g0 = *(const GAS f32x4*)(grow + 32 * ks), g1 = *(const GAS f32x4*)(grow + 32 * ks + 4);
                const f32x4 x0 = h0 * rstd * g0, x1 = h1 * rstd * g1;
                u32x4 hi; hi.x = cvt_pk_bf16(x0[0], x0[1]); hi.y = cvt_pk_bf16(x0[2], x0[3]); hi.z = cvt_pk_bf16(x1[0], x1[1]); hi.w = cvt_pk_bf16(x1[2], x1[3]);
                *(GAS u32x4*)(xrow + 32 * ks) = hi;
                u32x4 lo; lo.x = cvt_pk_bf16(x0[0] - bflo(hi.x), x0[1] - bfhi(hi.x)); lo.y = cvt_pk_bf16(x0[2] - bflo(hi.y), x0[3] - bfhi(hi.y));
                lo.z = cvt_pk_bf16(x1[0] - bflo(hi.z), x1[1] - bfhi(hi.z)); lo.w = cvt_pk_bf16(x1[2] - bflo(hi.w), x1[3] - bfhi(hi.w));
                const bf16x8 ahi = __builtin_bit_cast(bf16x8, hi), alo = __builtin_bit_cast(bf16x8, lo);
#pragma unroll
                for (int nt = 0; nt < 3; ++nt) {
                    const bf16x8 bh = *(const GAS bf16x8*)(whi + (size_t)(16 * nt) * D + 32 * ks), bl = *(const GAS bf16x8*)(wlo + (size_t)(16 * nt) * D + 32 * ks);
                    acc[nt] = __builtin_amdgcn_mfma_f32_16x16x32_bf16(ahi, bh, acc[nt], 0, 0, 0);
                    acc[nt] = __builtin_amdgcn_mfma_f32_16x16x32_bf16(ahi, bl, acc[nt], 0, 0, 0);
                    acc[nt] = __builtin_amdgcn_mfma_f32_16x16x32_bf16(alo, bh, acc[nt], 0, 0, 0);
                }
            }
#pragma unroll
            for (int nt = 0; nt < 3; ++nt)
#pragma unroll
                for (int i = 0; i < 4; ++i) lg[(4 * g + i) * 48 + 16 * nt + tr] = acc[nt][i];
            LDS_WAIT();
            if (lane < 16) {
                const LAS float* l = lg + lane * 48;
                float gl[4];
#pragma unroll
                for (int i = 0; i < 4; ++i) gl[i] = l[i] + brg[i];
                int gs = 0; float gm = gl[0];
#pragma unroll
                for (int i = 1; i < 4; ++i) if (gl[i] > gm) { gm = gl[i]; gs = i; }
                float gsum = 0.f;
#pragma unroll
                for (int i = 0; i < 4; ++i) gsum += __expf(gl[i] - gm);
                const float pg = 1.f / gsum;
                float el[8];
#pragma unroll
                for (int i = 0; i < 8; ++i) el[i] = l[4 + gs * 8 + i] + bre[gs * 8 + i];
                float em = el[0];
#pragma unroll
                for (int i = 1; i < 8; ++i) em = fmaxf(em, el[i]);
                float pe[8], esum = 0.f;
#pragma unroll
                for (int i = 0; i < 8; ++i) { pe[i] = __expf(el[i] - em); esum += pe[i]; }
#pragma unroll
                for (int i = 0; i < 8; ++i) pe[i] /= esum;
                int i1 = 0; float v1 = pe[0];
#pragma unroll
                for (int i = 1; i < 8; ++i) if (pe[i] > v1) { v1 = pe[i]; i1 = i; }
                int i2 = -1; float v2 = -1.f;
#pragma unroll
                for (int i = 0; i < 8; ++i) if (i != i1 && pe[i] > v2) { v2 = pe[i]; i2 = i; }
                const float tw = v1 + v2;
                w1 = v1 / tw * pg; w2 = v2 / tw * pg; e1 = gs * 8 + i1; e2 = gs * 8 + i2;
                p1 = (int)__hip_atomic_fetch_add((LAS unsigned*)&lcnt[e1], 1u, __ATOMIC_RELAXED, __HIP_MEMORY_SCOPE_WORKGROUP);
                p2 = (int)__hip_atomic_fetch_add((LAS unsigned*)&lcnt[e2], 1u, __ATOMIC_RELAXED, __HIP_MEMORY_SCOPE_WORKGROUP);
            }
        }
        __syncthreads();
        if (tid < NEXP) { const unsigned c = lcnt[tid]; lbase[tid] = c ? __hip_atomic_fetch_add(gcnt + tid, c, __ATOMIC_RELAXED, __HIP_MEMORY_SCOPE_AGENT) : 0u; lcnt[tid] = 0u; }
        __syncthreads();
        if (act && lane < 16) {
            const int s1 = e1 * NTOK + (int)lbase[e1] + p1, s2 = e2 * NTOK + (int)lbase[e2] + p2;
            LIST[s1] = tok * 2; LW[s1] = w1; LIST[s2] = tok * 2 + 1; LW[s2] = w2;
        }
        __syncthreads();
    }
}
namespace at {
typedef const LAS char* lds_cptr;
typedef short v4i16_t __attribute__((ext_vector_type(4)));
__device__ __forceinline__ int crow(int r, int hi) { return (r & 3) + 8 * (r >> 2) + 4 * hi; }
__device__ __forceinline__ void glds16(const void* gsrc, unsigned lds_dst) { unsigned keep;
    asm volatile("s_mov_b32 %0, m0\n\ts_mov_b32 m0, %2\n\ts_nop 0\n\tglobal_load_lds_dwordx4 %1, off\n\ts_mov_b32 m0, %0" : "=&s"(keep) : "v"(gsrc), "s"(lds_dst) : "memory"); }
#define AT_WAIT_BAR() asm volatile("s_waitcnt vmcnt(0) lgkmcnt(0)\n\ts_barrier" ::: "memory")
#define AT_BAR() asm volatile("s_waitcnt lgkmcnt(0)\n\ts_barrier" ::: "memory")
__device__ __forceinline__ unsigned cvtpk(float lo, float hi) { typedef float f2 __attribute__((ext_vector_type(2))); typedef __bf16 b2 __attribute__((ext_vector_type(2))); f2 v = {lo, hi}; b2 b = __builtin_convertvector(v, b2); return __builtin_bit_cast(unsigned, b); }
__device__ __forceinline__ s16x4 vtr(lds_cptr p) { return __builtin_bit_cast(s16x4, __builtin_amdgcn_ds_read_tr16_b64_v4i16((LAS v4i16_t*)p)); }

__device__ __forceinline__ int kpiece(int r32, int hi, int d0) { return ((2 * d0 + hi) ^ (r32 & 7)) * 16; }
__device__ __forceinline__ int ksrc_piece(int lane) { return ((lane & 7) ^ (lane >> 3)) * 8; }
__device__ __forceinline__ void qkt(f32x16& p0, f32x16& p1, lds_cptr Kslot, const bf16x8* qr, int r32, int hi) {
    lds_cptr kb = Kslot + r32 * 128;
    p0 = (f32x16){}; p1 = (f32x16){};
#pragma unroll
    for (int d0 = 0; d0 < 4; ++d0) {
        const bf16x8 b0 = *(const LAS bf16x8*)(kb + kpiece(r32, hi, d0));
        const bf16x8 b1 = *(const LAS bf16x8*)(kb + kpiece(r32, hi, d0) + 4096);
        p0 = __builtin_amdgcn_mfma_f32_32x32x16_bf16(b0, qr[d0], p0, 0, 0, 0);
        p1 = __builtin_amdgcn_mfma_f32_32x32x16_bf16(b1, qr[d0], p1, 0, 0, 0);
    }
}
__device__ __forceinline__ int vlane(int lane) { const int hi = lane >> 5; return ((lane >> 4) & 1) * 32 + (lane & 3) * 8 + (4 * hi + ((lane & 15) >> 2)) * 64; }
template <int NB> __device__ __forceinline__ void pv(f32x16* o, lds_cptr vp, const u32x4& pw0, const u32x4& pw1, const u32x4& pw2, const u32x4& pw3) {
#pragma unroll
    for (int d0 = 0; d0 < NB; ++d0) { s16x4 lo[4], hi[4];
#pragma unroll
        for (int ks = 0; ks < 4; ++ks) { lo[ks] = vtr(vp + d0 * 4096 + ks * 1024); hi[ks] = vtr(vp + d0 * 4096 + ks * 1024 + 512); }
#define AT_PK(k) (bf16x8){lo[k][0], lo[k][1], lo[k][2], lo[k][3], hi[k][0], hi[k][1], hi[k][2], hi[k][3]}
        o[d0] = __builtin_amdgcn_mfma_f32_32x32x16_bf16(__builtin_bit_cast(bf16x8, pw0), AT_PK(0), o[d0], 0, 0, 0);
        o[d0] = __builtin_amdgcn_mfma_f32_32x32x16_bf16(__builtin_bit_cast(bf16x8, pw1), AT_PK(1), o[d0], 0, 0, 0);
        o[d0] = __builtin_amdgcn_mfma_f32_32x32x16_bf16(__builtin_bit_cast(bf16x8, pw2), AT_PK(2), o[d0], 0, 0, 0);
        o[d0] = __builtin_amdgcn_mfma_f32_32x32x16_bf16(__builtin_bit_cast(bf16x8, pw3), AT_PK(3), o[d0], 0, 0, 0);
#undef AT_PK
    }
}
__device__ __forceinline__ void load_k(bf16x8 (&kf)[8], lds_cptr Kslot, int r32, int hi) {
    lds_cptr kb = Kslot + r32 * 128;
#pragma unroll
    for (int d0 = 0; d0 < 4; ++d0) { kf[2 * d0] = *(const LAS bf16x8*)(kb + kpiece(r32, hi, d0)); kf[2 * d0 + 1] = *(const LAS bf16x8*)(kb + kpiece(r32, hi, d0) + 4096); }
}
__device__ __forceinline__ void qkt_r(f32x16& p0, f32x16& p1, const bf16x8 (&kf)[8], const bf16x8* qr) {
    p0 = (f32x16){}; p1 = (f32x16){};
#pragma unroll
    for (int d0 = 0; d0 < 4; ++d0) { p0 = __builtin_amdgcn_mfma_f32_32x32x16_bf16(kf[2 * d0], qr[d0], p0, 0, 0, 0); p1 = __builtin_amdgcn_mfma_f32_32x32x16_bf16(kf[2 * d0 + 1], qr[d0], p1, 0, 0, 0); }
}
__device__ __forceinline__ int vlane2(int lane, int d0) { const int hi = lane >> 5, q = (lane & 15) >> 2; return (4 * hi + q) * 128 + ((d0 ^ ((q >> 1) & 1)) * 64) + ((lane >> 4) & 1) * 32 + (lane & 3) * 8; }
__device__ __forceinline__ int vsrc_piece(int lane) { return ((lane & 7) ^ ((((lane >> 3) >> 1) & 1) << 2)) * 8; }
__device__ __forceinline__ void load_v2(s16x4 (&vlo)[8], s16x4 (&vhi)[8], lds_cptr slot, int va0, int va1) {
#pragma unroll
    for (int d0 = 0; d0 < 2; ++d0)
#pragma unroll
        for (int ks = 0; ks < 4; ++ks) { vlo[d0 * 4 + ks] = vtr(slot + (d0 ? va1 : va0) + ks * 2048); vhi[d0 * 4 + ks] = vtr(slot + (d0 ? va1 : va0) + ks * 2048 + 1024); }
}
__device__ __forceinline__ void pv2_r(f32x16* o, const s16x4 (&vlo)[8], const s16x4 (&vhi)[8], const u32x4& pw0, const u32x4& pw1, const u32x4& pw2, const u32x4& pw3) {
#define AT_PKR(i) (bf16x8){vlo[i][0], vlo[i][1], vlo[i][2], vlo[i][3], vhi[i][0], vhi[i][1], vhi[i][2], vhi[i][3]}
#pragma unroll
    for (int d0 = 0; d0 < 2; ++d0) {
        o[d0] = __builtin_amdgcn_mfma_f32_32x32x16_bf16(__builtin_bit_cast(bf16x8, pw0), AT_PKR(d0 * 4 + 0), o[d0], 0, 0, 0);
        o[d0] = __builtin_amdgcn_mfma_f32_32x32x16_bf16(__builtin_bit_cast(bf16x8, pw1), AT_PKR(d0 * 4 + 1), o[d0], 0, 0, 0);
        o[d0] = __builtin_amdgcn_mfma_f32_32x32x16_bf16(__builtin_bit_cast(bf16x8, pw2), AT_PKR(d0 * 4 + 2), o[d0], 0, 0, 0);
        o[d0] = __builtin_amdgcn_mfma_f32_32x32x16_bf16(__builtin_bit_cast(bf16x8, pw3), AT_PKR(d0 * 4 + 3), o[d0], 0, 0, 0); }
#undef AT_PKR
}
__device__ __forceinline__ void qkt_ri(f32x16& p0, f32x16& p1, const bf16x8 (&kf)[8], const bf16x8* qr, const f32x16& i0, const f32x16& i1) {
    p0 = __builtin_amdgcn_mfma_f32_32x32x16_bf16(kf[0], qr[0], i0, 0, 0, 0); p1 = __builtin_amdgcn_mfma_f32_32x32x16_bf16(kf[1], qr[0], i1, 0, 0, 0);
#pragma unroll
    for (int d0 = 1; d0 < 4; ++d0) { p0 = __builtin_amdgcn_mfma_f32_32x32x16_bf16(kf[2 * d0], qr[d0], p0, 0, 0, 0); p1 = __builtin_amdgcn_mfma_f32_32x32x16_bf16(kf[2 * d0 + 1], qr[d0], p1, 0, 0, 0); }
}
__device__ __forceinline__ float rowmax32(const f32x16& p0, const f32x16& p1) {
    float a = fmaxf(p0[0], p1[0]);
#pragma unroll
    for (int r = 1; r < 16; ++r) a = fmaxf(a, fmaxf(p0[r], p1[r]));
    auto rr = __builtin_amdgcn_permlane32_swap(__float_as_uint(a), __float_as_uint(a), false, false);
    return fmaxf(__uint_as_float(rr[0]), __uint_as_float(rr[1]));
}
template <int NB> __device__ __forceinline__ void softmax_step(f32x16& p0, f32x16& p1, float& m, float& l, f32x16* o, LAS float* wsf, int r32, int hi, u32x4& pw0, u32x4& pw1, u32x4& pw2, u32x4& pw3) {
    const float rm = rowmax32(p0, p1);
    const float mn = fmaxf(m, rm);
    const float alpha = __builtin_amdgcn_exp2f(m - mn);
    m = mn;
    const bool resc = !__all(alpha == 1.f);
    if (resc && hi == 0) wsf[r32] = alpha;
    float s = 0.f;
#pragma unroll
    for (int r = 0; r < 16; ++r) { p0[r] = __builtin_amdgcn_exp2f(p0[r] - mn); p1[r] = __builtin_amdgcn_exp2f(p1[r] - mn); s += p0[r] + p1[r]; }
    l = l * alpha + s;
    pw0 = (u32x4){cvtpk(p0[0], p0[1]), cvtpk(p0[2], p0[3]), cvtpk(p0[4], p0[5]), cvtpk(p0[6], p0[7])};
    pw1 = (u32x4){cvtpk(p0[8], p0[9]), cvtpk(p0[10], p0[11]), cvtpk(p0[12], p0[13]), cvtpk(p0[14], p0[15])};
    pw2 = (u32x4){cvtpk(p1[0], p1[1]), cvtpk(p1[2], p1[3]), cvtpk(p1[4], p1[5]), cvtpk(p1[6], p1[7])};
    pw3 = (u32x4){cvtpk(p1[8], p1[9]), cvtpk(p1[10], p1[11]), cvtpk(p1[12], p1[13]), cvtpk(p1[14], p1[15])};
    if (resc) {
        LDS_WAIT();
#pragma unroll
        for (int g = 0; g < 4; ++g) { const f32x4 a = *(const LAS f32x4*)(wsf + 8 * g + 4 * hi);
#pragma unroll
            for (int d = 0; d < NB; ++d) { o[d][4 * g + 0] *= a[0]; o[d][4 * g + 1] *= a[1]; o[d][4 * g + 2] *= a[2]; o[d][4 * g + 3] *= a[3]; } }
    }
}
template <int NB> __device__ __forceinline__ bool softmax_def(f32x16& p0, f32x16& p1, float& mh, float& l, f32x16* o, LAS float* wsf, int r32, int hi, bool first, u32x4& pw0, u32x4& pw1, u32x4& pw2, u32x4& pw3) {
    const float rm = rowmax32(p0, p1);
    const bool trig = first || __any(rm > 8.f);
    if (trig) {
        const float dl = first ? rm : fmaxf(rm, 0.f);
        mh += dl;
#pragma unroll
        for (int r = 0; r < 16; ++r) { p0[r] -= dl; p1[r] -= dl; }
        if (!first) {
            const float f = __builtin_amdgcn_exp2f(-dl);
            l *= f;
            if (hi == 0) wsf[r32] = f;
            LDS_WAIT();
#pragma unroll
            for (int g = 0; g < 4; ++g) { const f32x4 a = *(const LAS f32x4*)(wsf + 8 * g + 4 * hi);
#pragma unroll
                for (int d = 0; d < NB; ++d) { o[d][4 * g + 0] *= a[0]; o[d][4 * g + 1] *= a[1]; o[d][4 * g + 2] *= a[2]; o[d][4 * g + 3] *= a[3]; } }
        }
    }
    float s = 0.f;
#pragma unroll
    for (int r = 0; r < 16; ++r) { p0[r] = __builtin_amdgcn_exp2f(p0[r]); p1[r] = __builtin_amdgcn_exp2f(p1[r]); s += p0[r] + p1[r]; }
    l += s;
    pw0 = (u32x4){cvtpk(p0[0], p0[1]), cvtpk(p0[2], p0[3]), cvtpk(p0[4], p0[5]), cvtpk(p0[6], p0[7])};
    pw1 = (u32x4){cvtpk(p0[8], p0[9]), cvtpk(p0[10], p0[11]), cvtpk(p0[12], p0[13]), cvtpk(p0[14], p0[15])};
    pw2 = (u32x4){cvtpk(p1[0], p1[1]), cvtpk(p1[2], p1[3]), cvtpk(p1[4], p1[5]), cvtpk(p1[6], p1[7])};
    pw3 = (u32x4){cvtpk(p1[8], p1[9]), cvtpk(p1[10], p1[11]), cvtpk(p1[12], p1[13]), cvtpk(p1[14], p1[15])};
    return trig;
}
__device__ __forceinline__ void row_scales(float l, LAS float* wsf, int r32, int hi, float scale, float (&rl)[16]) {
    auto rr = __builtin_amdgcn_permlane32_swap(__float_as_uint(l), __float_as_uint(l), false, false);
    const float lt = __uint_as_float(rr[0]) + __uint_as_float(rr[1]);
    LDS_WAIT();
    if (hi == 0) wsf[32 + r32] = scale * __builtin_amdgcn_rcpf(lt);
    LDS_WAIT();
#pragma unroll
    for (int g = 0; g < 4; ++g) { const f32x4 a = *(const LAS f32x4*)(wsf + 32 + 8 * g + 4 * hi); rl[4 * g] = a[0]; rl[4 * g + 1] = a[1]; rl[4 * g + 2] = a[2]; rl[4 * g + 3] = a[3]; }
}
}

__device__ __forceinline__ void attn_c_phase(LAS unsigned char* lds, const bf16_t* QKV, const float* rel, bf16_t* ATT, int vcu, int G, int wave, int lane, int tid) {
    using namespace at;
    constexpr int WS_OFF = 98304, OST_OFF = 0;
    const int r32 = lane & 31, hi = lane >> 5;
    const int hh = wave >> 2, cc = (wave >> 1) & 1, rh = wave & 1;
    LAS float* wsf = (LAS float*)(lds + WS_OFF) + wave * 64;
    LAS float* tab = (LAS float*)(lds + TAB_OFF);
    const unsigned lds0 = (unsigned)(uintptr_t)lds;
    const int va0 = vlane2(lane, 0), va1 = vlane2(lane, 1);
    constexpr int NUNIT = BATCH * 8 * 32;
    int cur_hp = -1;
    for (int u = vcu; u < NUNIT; u += G) {
        const int b = u >> 8, hp = (u >> 5) & 7, cp = u & 31;
        if (hp != cur_hp) {
            AT_BAR();
            for (int i = tid; i < 2 * 640; i += NWAVES * 64) { const int h2 = i / 640, idx = i % 640; int d = idx - 63; d = d < -128 ? -128 : (d > 128 ? 128 : d); tab[i] = rel[(d + 128) * 16 + 2 * hp + h2] * LOG2E; }
            cur_hp = hp;
            AT_BAR();
        }
        const int head = 2 * hp + hh, qchunk = 2 * cp + cc;
        const size_t rowbase = (size_t)b * SEQ;
        bf16x8 qr[4];
        { const bf16_t* qp = QKV + (rowbase + qchunk * 64 + 32 * rh + r32) * C_IN + head * 64 + 8 * hi;
#pragma unroll
          for (int d0 = 0; d0 < 4; ++d0) qr[d0] = *(const GAS bf16x8*)(qp + 16 * d0); }
        const int j0 = (2 * cp - 8 < 0) ? (8 - 2 * cp) : 0;
        const bf16_t* ksrc = QKV + (rowbase + 8 * wave + (lane >> 3)) * C_IN + 1024 + (2 * hp) * 64 + ksrc_piece(lane);
        const bf16_t* vsrc = QKV + (rowbase + 8 * wave + (lane >> 3)) * C_IN + 2048 + (2 * hp) * 64 + vsrc_piece(lane);
#define DMA_TILE(j, buf) do { const size_t ro_ = (size_t)((2 * cp - 8 + (j)) * 64) * C_IN; const unsigned d_ = (unsigned)__builtin_amdgcn_readfirstlane(lds0 + (buf) * 32768 + wave * 1024); \
        glds16(ksrc + ro_, d_); glds16(ksrc + ro_ + 64, d_ + 8192); glds16(vsrc + ro_, d_ + 16384); glds16(vsrc + ro_ + 64, d_ + 24576); } while (0)
        float mh = 0.f, l = 0.f; f32x16 o[2]; o[0] = (f32x16){}; o[1] = (f32x16){};
        const float cb = tab[hh * 640 + 63 + 128]; f32x16 cfar; bool first = true;
#pragma unroll
        for (int r = 0; r < 16; ++r) cfar[r] = cb;
        DMA_TILE(j0, 0); if (j0 + 1 < 10) DMA_TILE(j0 + 1, 1);
        int buf = 0; bool have_k = false; bf16x8 kf[8];
        for (int j = j0; j < 10; ++j) {
            AT_WAIT_BAR();
            if (j + 2 < 10) DMA_TILE(j + 2, (buf == 0) ? 2 : buf - 1);
            const int bufn = (buf == 2) ? 0 : buf + 1;
            const bool act = (j >= cc && j <= cc + 8), actn = (j + 1 < 10) && (j + 1 >= cc && j + 1 <= cc + 8);
            if (act) {
                lds_cptr Vs = (lds_cptr)(lds + buf * 32768 + 16384 + hh * 8192);
                if (!have_k) load_k(kf, (lds_cptr)(lds + buf * 32768 + hh * 8192), r32, hi);
                s16x4 vlo[8], vhi[8];
                load_v2(vlo, vhi, Vs, va0, va1);
                const int dl = cc + 8 - j;
                f32x16 p0, p1;
                if (dl >= 3) qkt_ri(p0, p1, kf, qr, cfar, cfar);
                else { const LAS float* tp = tab + hh * 640 + (dl * 64 + 32 * rh + r32 - 4 * hi);
                    f32x16 b0, b1;
#pragma unroll
                    for (int r = 0; r < 16; ++r) { b0[r] = tp[63 - ((r & 3) + 8 * (r >> 2))] - mh; b1[r] = tp[31 - ((r & 3) + 8 * (r >> 2))] - mh; }
                    qkt_ri(p0, p1, kf, qr, b0, b1); }
                if (actn) load_k(kf, (lds_cptr)(lds + bufn * 32768 + hh * 8192), r32, hi);
                u32x4 pw0, pw1, pw2, pw3;
                if (softmax_def<2>(p0, p1, mh, l, o, wsf, r32, hi, first, pw0, pw1, pw2, pw3)) {
#pragma unroll
                    for (int r = 0; r < 16; ++r) cfar[r] = cb - mh; }
                first = false;
                pv2_r(o, vlo, vhi, pw0, pw1, pw2, pw3);
            } else if (actn) load_k(kf, (lds_cptr)(lds + bufn * 32768 + hh * 8192), r32, hi);
            have_k = actn;
            buf = bufn;
        }
#undef DMA_TILE
        float rl[16]; row_scales(l, wsf, r32, hi, 1.f, rl);
        AT_BAR();
        { LAS bf16_t* stg = (LAS bf16_t*)(lds + OST_OFF) + wave * 2048;
#pragma unroll
          for (int r = 0; r < 16; ++r) { const int orow = crow(r, hi);
#pragma unroll
              for (int d0 = 0; d0 < 2; ++d0) stg[orow * 64 + d0 * 32 + r32] = (bf16_t)f2bf(o[d0][r] * rl[r]); }
          LDS_WAIT();
          bf16_t* Ow = ATT + (rowbase + qchunk * 64 + 32 * rh) * D + head * 64;
#pragma unroll
          for (int i = 0; i < 4; ++i) { const int row = i * 8 + (lane >> 3), ch = lane & 7; const u32x4 v = *(const LAS u32x4*)(stg + row * 64 + ch * 8); *(GAS u32x4*)(Ow + (size_t)row * D + ch * 8) = v; } }
        AT_BAR();
    }
}

__device__ __forceinline__ void attn_a_build_tab(LAS unsigned char* lds, const float* t5, int tid) {
    LAS float* tab = (LAS float*)(lds + TAB_OFF);
    for (int i = tid; i < 4 * 768; i += NWAVES * 64) { const int h = i / 768, d = (i % 768) - 63; tab[i] = t5[t5_bucket(-d) * 12 + h] * LOG2E; }
}
__device__ __forceinline__ void attn_a_unit(LAS unsigned char* lds, const bf16_t* PROJ, const float* subln, float lam, bf16_t* ATT, int b, int h, int qb, int wave, int lane) {
    using namespace at;
    constexpr int WS_OFF = 98304, XROW = 132;
    const int r32 = lane & 31, hi = lane >> 5;
    const int mm = wave & 1, rg = wave >> 1;
    LAS float* wsf = (LAS float*)(lds + WS_OFF) + wave * 64;
    const LAS float* tab = (const LAS float*)(lds + TAB_OFF) + h * 768;
    const unsigned lds0 = (unsigned)(uintptr_t)lds;
    const int va0 = vlane2(lane, 0), va1 = vlane2(lane, 1);
    const size_t rowbase = (size_t)b * SEQ;
    const int qw0 = 128 * qb + 32 * rg;
    const int cq = qw0 >> 6;
    const int NT = 2 * qb + 2;
    bf16x8 qr[4];
    { const bf16_t* qp = PROJ + (rowbase + qw0 + r32) * AB_INP + h * 128 + mm * 64 + 8 * hi;
#pragma unroll
      for (int d0 = 0; d0 < 4; ++d0) qr[d0] = *(const GAS bf16x8*)(qp + 16 * d0); }
    const bf16_t* ksrc = PROJ + (rowbase + 8 * wave + (lane >> 3)) * AB_INP + 512 + h * 128 + ksrc_piece(lane);
    const bf16_t* vsrc0 = PROJ + (rowbase + 8 * (wave >> 1) + (lane >> 3)) * AB_INP + 1024 + h * 128 + (wave & 1) * 64 + vsrc_piece(lane);
    const bf16_t* vsrc1 = vsrc0 + (size_t)32 * AB_INP;
#define DMA_TILE(t, buf) do { const size_t ro_ = (size_t)((t) * 64) * AB_INP; const unsigned d_ = (unsigned)__builtin_amdgcn_readfirstlane(lds0 + (buf) * 32768 + wave * 1024); \
        const unsigned dv_ = (unsigned)__builtin_amdgcn_readfirstlane(lds0 + (buf) * 32768 + 16384 + (wave & 1) * 8192 + (wave >> 1) * 1024); \
        glds16(ksrc + ro_, d_); glds16(ksrc + ro_ + 64, d_ + 8192); glds16(vsrc0 + ro_, dv_); glds16(vsrc1 + ro_, dv_ + 4096); } while (0)
    float mh = 0.f, l = 0.f; f32x16 o[4]; o[0] = (f32x16){}; o[1] = (f32x16){}; o[2] = (f32x16){}; o[3] = (f32x16){};
    const float c15 = tab[700];
    bool first = true;
    DMA_TILE(0, 0); DMA_TILE(1, 1);
    int buf = 0;
    for (int t = 0; t < NT; ++t) {
        if (t + 1 < NT) asm volatile("s_waitcnt vmcnt(4) lgkmcnt(0)\n\ts_barrier" ::: "memory"); else AT_WAIT_BAR();
        if (t + 2 < NT) DMA_TILE(t + 2, (buf == 0) ? 2 : buf - 1);
        if (t <= cq) {
            lds_cptr Vs = (lds_cptr)(lds + buf * 32768 + 16384);
            f32x16 p0, p1;
            { bf16x8 kf[8];
              load_k(kf, (lds_cptr)(lds + buf * 32768 + mm * 8192), r32, hi);
              const int dmin = qw0 - (64 * t + 63);
              f32x16 b0, b1;
              if (dmin >= 559) { const float c = c15 - mh;
#pragma unroll
                  for (int r = 0; r < 16; ++r) b0[r] = c;
                  qkt_ri(p0, p1, kf, qr, b0, b0); }
              else { const LAS float* tp = tab + (qw0 - 64 * t + r32 - 4 * hi);
#pragma unroll
                  for (int r = 0; r < 16; ++r) { b0[r] = tp[63 - ((r & 3) + 8 * (r >> 2))] - mh; b1[r] = tp[31 - ((r & 3) + 8 * (r >> 2))] - mh; }
                  qkt_ri(p0, p1, kf, qr, b0, b1); } }
            s16x4 vlo[8], vhi[8];
            load_v2(vlo, vhi, Vs, va0, va1);
            u32x4 pw0, pw1, pw2, pw3;
            (void)softmax_def<4>(p0, p1, mh, l, o, wsf, r32, hi, first, pw0, pw1, pw2, pw3);
            first = false;
            pv2_r(o, vlo, vhi, pw0, pw1, pw2, pw3);
            load_v2(vlo, vhi, Vs + 8192, va0, va1);
            pv2_r(o + 2, vlo, vhi, pw0, pw1, pw2, pw3);
        }
        buf = (buf == 2) ? 0 : buf + 1;
    }
#undef DMA_TILE
    float rl[16]; row_scales(l, wsf, r32, hi, mm ? -lam : 1.f, rl);
    LAS float* X = (LAS float*)lds + rg * (32 * XROW);
    AT_BAR();
    if (mm == 1) {
#pragma unroll
        for (int blk = 0; blk < 4; ++blk)
#pragma unroll
            for (int r = 0; r < 16; ++r) X[crow(r, hi) * XROW + blk * 32 + r32] = o[blk][r] * rl[r];
    }
    AT_BAR();
    if (mm == 0) {
#pragma unroll
        for (int blk = 0; blk < 4; ++blk)
#pragma unroll
            for (int r = 0; r < 16; ++r) X[crow(r, hi) * XROW + blk * 32 + r32] += o[blk][r] * rl[r];
        LDS_WAIT();
        const int row = lane >> 1, half = lane & 1;
        const LAS float* xr = X + row * XROW + half * 64;
        f32x4 v[16]; float ss = 0.f;
#pragma unroll
        for (int k = 0; k < 16; ++k) { v[k] = *(const LAS f32x4*)(xr + 4 * k); ss += (v[k][0] * v[k][0] + v[k][1] * v[k][1]) + (v[k][2] * v[k][2] + v[k][3] * v[k][3]); }
        ss += __shfl_xor(ss, 1);
        const float sc = __builtin_amdgcn_rsqf(ss * (1.f / 128.f) + EPS) * 0.8f;
        bf16_t* op = ATT + (rowbase + qw0 + row) * D + h * 128 + half * 64;
        const float* sg = subln + half * 64;
#pragma unroll
        for (int k = 0; k < 8; ++k) { const f32x4 g0 = *(const GAS f32x4*)(sg + 8 * k), g1 = *(const GAS f32x4*)(sg + 8 * k + 4); const f32x4 a = v[2 * k] * sc * g0, c = v[2 * k + 1] * sc * g1;
            u32x4 w; w.x = cvt_pk_bf16(a[0], a[1]); w.y = cvt_pk_bf16(a[2], a[3]); w.z = cvt_pk_bf16(c[0], c[1]); w.w = cvt_pk_bf16(c[2], c[3]);
            *(GAS u32x4*)(op + 8 * k) = w; }
    }
    AT_BAR();
}
__device__ __forceinline__ void attn_a_phase(LAS unsigned char* lds, const bf16_t* PROJ, const float* t5, const float* subln, float lam, bf16_t* ATT, int vcu, int G, int wave, int lane, int tid) {
    AT_BAR();
    attn_a_build_tab(lds, t5, tid);
    AT_BAR();
    for (int p = vcu; p < 512; p += G) {
        const int bh = p >> 4, s = p & 15;
#pragma unroll 1
        for (int k = 0; k < 2; ++k) attn_a_unit(lds, PROJ, subln, lam, ATT, bh >> 2, bh & 3, k ? 31 - s : s, wave, lane);
    }
}

#ifndef BM_SELREP
#define BM_SELREP 1
#endif
#ifndef BM_ATTREP
#define BM_ATTREP 1
#endif
namespace bm {
using namespace at;
constexpr int GT_OFF = 0, EQ_OFF = 16384, CAND_OFF = 32768, CCNT_OFF = 32768 + 4096, SEL_OFF = 98304, VIMG_OFF = 0, QI_OFF = TAB_OFF + 10240, LOINV_OFF = TAB_OFF + 26624;
__device__ __forceinline__ unsigned sortable(float f) { const unsigned u = __float_as_uint(f); return (u & 0x80000000u) ? ~u : (u | 0x80000000u); }
__device__ __forceinline__ void load_kf(bf16x8 (&kf)[4], const bf16_t* kbase, int wave, int i, int r32, int hi) {
    const bf16_t* kp = kbase + (size_t)(64 * (wave + 8 * (i >> 1)) + 32 * (i & 1) + r32) * AB_INP + 8 * hi;
#pragma unroll
    for (int d0 = 0; d0 < 4; ++d0) kf[d0] = *(const GAS bf16x8*)(kp + 16 * d0);
}
__device__ __forceinline__ void half_scores(f32x16& a, const bf16x8 (&kf)[4], lds_cptr qfl, const float (&wq)[4]) {
    a = (f32x16){};
#pragma unroll
    for (int hh = 0; hh < 4; ++hh) { f32x16 p = (f32x16){};
#pragma unroll
        for (int d0 = 0; d0 < 4; ++d0) p = __builtin_amdgcn_mfma_f32_32x32x16_bf16(kf[d0], *(const LAS bf16x8*)(qfl + (hh * 4 + d0) * 1024), p, 0, 0, 0);
#pragma unroll
        for (int r = 0; r < 16; ++r) a[r] = __builtin_fmaf(fmaxf(p[r], 0.f), wq[hh], a[r]);
        __builtin_amdgcn_sched_barrier(0); }
}
__device__ __forceinline__ float unsortable(unsigned k) { return __uint_as_float((k & 0x80000000u) ? (k & 0x7fffffffu) : ~k); }
__device__ __forceinline__ int linbin0(float a, float lo, float invw) { int b = (int)((a - lo) * invw); b = b < 1 ? 1 : b; return b > 2046 ? 2046 : b; }
__device__ __forceinline__ int linbin(float a, float lo, float invw, int zb) { const int b = linbin0(a, lo, invw); return a > 0.f ? (b > zb ? b : zb) + 1 : (a == 0.f ? zb : (b < zb ? b : zb) - 1); }
__device__ __forceinline__ void unit(LAS unsigned char* lds, volatile LAS unsigned* MISC, const bf16_t* PROJ, bf16_t* ATT, unsigned* kc, int b, int qg, int wave, int lane_in, int tid_in) {
    const size_t rowbase = (size_t)b * SEQ;
    const int q0 = 32 * qg, ntile = (q0 >> 6) + 1, nk = 64 * ntile;
    const bf16_t* kbase = PROJ + rowbase * AB_INP + 2432;
    LAS unsigned short* sel = (LAS unsigned short*)(lds + SEL_OFF);
    LAS unsigned* hist = (LAS unsigned*)lds;
    const int ns = nk < 256 ? nk : 256;
    AT_BAR();
    __builtin_amdgcn_fence(__ATOMIC_ACQUIRE, "agent");
    bool fast = false;
    if (ntile > 4) {
        float wq[4];
        { const int r32 = lane_in & 31; const bf16_t* qp = PROJ + (rowbase + q0 + r32) * AB_INP;
#pragma unroll
          for (int hh = 0; hh < 4; ++hh) wq[hh] = bf2f(qp[2496 + hh]) * 0.0625f;
#pragma unroll
          for (int i = 0; i < 2; ++i) { const int pc = tid_in + 512 * i, q = pc & 31, hi2 = (pc >> 5) & 1, f = pc >> 6;
              *(LAS u32x4*)(lds + QI_OFF + pc * 16) = *(const GAS u32x4*)(PROJ + (rowbase + q0 + q) * AB_INP + 2176 + (f >> 2) * 64 + 16 * (f & 3) + 8 * hi2); }
#pragma unroll 1
          for (int i = 0; i < 16; ++i) *(LAS u32x4*)(lds + (i * 512 + tid_in) * 16) = (u32x4){0u, 0u, 0u, 0u};
          if (tid_in < 32) { MISC[128 + 2 * tid_in] = 0u; MISC[129 + 2 * tid_in] = 256u; }
          if (tid_in == 0) MISC[232] = 0u; }
        AT_BAR();
        { int tid = tid_in, lane = lane_in; asm volatile("" : "+v"(tid), "+v"(lane));
          const int r32 = lane & 31, hi = lane >> 5;
          LAS unsigned* hq = hist + r32 * 1024;
          lds_cptr qfl = (lds_cptr)(lds + QI_OFF + hi * 512 + r32 * 16);
          const int nhalf = 2 * ((ntile - wave + NWAVES - 1) / NWAVES);
          GAS u32x4* kcw = (GAS u32x4*)kc + (size_t)(wave * 16) * 256 + lane;
          bf16x8 kf3[4][4];
          if (nhalf > 0) load_kf(kf3[0], kbase, wave, 0, r32, hi);
          if (nhalf > 1) load_kf(kf3[1], kbase, wave, 1, r32, hi);
          if (nhalf > 2) load_kf(kf3[2], kbase, wave, 2, r32, hi);
#pragma unroll 1
          for (int i0 = 0; i0 < nhalf; i0 += 4) {
#pragma unroll
              for (int u = 0; u < 4; ++u) { const int i = i0 + u;
                  if (i < nhalf) {
                      if (i + 3 < nhalf) load_kf(kf3[(u + 3) & 3], kbase, wave, i + 3, r32, hi);
                      f32x16 a;
                      half_scores(a, kf3[u], qfl, wq);
                      unsigned k[16];
#pragma unroll
                      for (int r = 0; r < 16; ++r) k[r] = sortable(a[r]);
#pragma unroll
                      for (int r4 = 0; r4 < 4; ++r4) kcw[(i * 4 + r4) * 64] = (u32x4){k[4 * r4], k[4 * r4 + 1], k[4 * r4 + 2], k[4 * r4 + 3]};
#pragma unroll
                      for (int r = 0; r < 16; ++r) { const unsigned bin = k[r] >> 21; (void)__hip_atomic_fetch_add(hq + (bin >> 1), 1u << ((bin & 1u) << 4), __ATOMIC_RELAXED, __HIP_MEMORY_SCOPE_WORKGROUP); }
                  } }
          } }
        AT_BAR();
#define BM_SCAN(PASSV) do { const int q = tid >> 4, j = tid & 15; const LAS unsigned* hqq = hist + q * 1024 + (1024 - 64 * (j + 1)); \
            unsigned c = 0; \
            _Pragma("unroll 4") for (int d = 0; d < 64; ++d) { const unsigned w = hqq[d]; c += (w & 0xffffu) + (w >> 16); } \
            unsigned cum = c; \
            _Pragma("unroll") for (int off = 1; off < 16; off <<= 1) { const unsigned tt = __shfl_up(cum, off, 16); if (j >= off) cum += tt; } \
            const unsigned need = MISC[129 + 2 * q], before = cum - c; \
            if (before < need && need <= cum) { \
                unsigned run = before, T = 0, nn = need, cT = 0; bool found = false; \
                _Pragma("unroll 1") for (int d = 63; d >= 0 && !found; --d) { const unsigned w = hqq[d]; const unsigned h16 = w >> 16, l16 = w & 0xffffu; const unsigned bidx = (unsigned)(1024 - 64 * (j + 1) + d); \
                    if (run + h16 >= need) { T = 2 * bidx + 1; nn = need - run; cT = h16; found = true; } \
                    else { run += h16; if (run + l16 >= need) { T = 2 * bidx; nn = need - run; cT = l16; found = true; } else run += l16; } } \
                const unsigned prf = MISC[128 + 2 * q]; \
                MISC[128 + 2 * q] = ((PASSV) <= 0) ? T : ((prf << ((PASSV) == 1 ? 11 : 10)) | T); MISC[129 + 2 * q] = nn; \
                if ((PASSV) == 1) { MISC[192 + q] = cT; if (cT > 16u) MISC[232] = 1u; } } } while (0)
        { int tid = tid_in; asm volatile("" : "+v"(tid)); BM_SCAN(0); }
        AT_BAR();
#pragma unroll 1
        for (int pass = 1; pass < 4; ++pass) {
            const unsigned shift = pass == 0 ? 21u : (pass == 1 ? 10u : 0u), bmask = pass == 2 ? 1023u : 2047u, cshift = pass == 1 ? 21u : 10u;
            int tid = tid_in, lane = lane_in; asm volatile("" : "+v"(tid), "+v"(lane));
            const int r32 = lane & 31, hi = lane >> 5;
            AT_BAR();
            if (pass < 3) {
#pragma unroll 1
                for (int i = 0; i < 16; ++i) *(LAS u32x4*)(lds + (i * 512 + tid) * 16) = (u32x4){0u, 0u, 0u, 0u};
            }
            AT_BAR();
            const unsigned pref = MISC[128 + 2 * r32];
            LAS unsigned* hq = hist + r32 * 1024;
            const int nhalf = 2 * ((ntile - wave + NWAVES - 1) / NWAVES);
            GAS u32x4* kcw = (GAS u32x4*)kc + (size_t)(wave * 16) * 256 + lane;
            {
                u32x4 kq[4], kqn[4];
                if (nhalf > 0) {
#pragma unroll
                    for (int r4 = 0; r4 < 4; ++r4) kq[r4] = kcw[r4 * 64]; }
                unsigned gm0 = 0u, em0 = 0u;
#pragma unroll 1
                for (int i = 0; i < nhalf; ++i) {
                    const int t = wave + 8 * (i >> 1), sh = i & 1;
                    if (i + 1 < nhalf) {
#pragma unroll
                        for (int r4 = 0; r4 < 4; ++r4) kqn[r4] = kcw[((i + 1) * 4 + r4) * 64]; }
                    if (pass < 3) {
#pragma unroll
                        for (int r = 0; r < 16; ++r) { const unsigned key = kq[r >> 2][r & 3], bin = (key >> shift) & bmask;
                            if ((key >> cshift) == pref) (void)__hip_atomic_fetch_add(hq + (bin >> 1), 1u << ((bin & 1u) << 4), __ATOMIC_RELAXED, __HIP_MEMORY_SCOPE_WORKGROUP); }
                    } else {
                        unsigned g_ = 0u, e_ = 0u;
#pragma unroll
                        for (int r = 0; r < 16; ++r) { const unsigned key = kq[r >> 2][r & 3], bit = 1u << ((r & 3) + 8 * (r >> 2)); g_ |= (key > pref) ? bit : 0u; e_ |= (key == pref) ? bit : 0u; }
                        if (sh == 0) { gm0 = g_; em0 = e_; }
                        else {
                            unsigned glo = gm0 << (4 * hi), ghi = g_ << (4 * hi), elo = em0 << (4 * hi), ehi = e_ << (4 * hi);
                            glo |= __shfl_xor(glo, 32); ghi |= __shfl_xor(ghi, 32); elo |= __shfl_xor(elo, 32); ehi |= __shfl_xor(ehi, 32);
                            if (hi == 0) { *(LAS u32x2*)(lds + GT_OFF + (r32 * 64 + t) * 8) = (u32x2){glo, ghi}; *(LAS u32x2*)(lds + EQ_OFF + (r32 * 64 + t) * 8) = (u32x2){elo, ehi}; }
                        }
                    }
#pragma unroll
                    for (int r4 = 0; r4 < 4; ++r4) kq[r4] = kqn[r4];
                }
            }
            AT_BAR();
            if (pass < 3) { BM_SCAN(pass); AT_BAR(); }
            if (pass == 1 && MISC[232] == 0u) { fast = true; break; }
        }
        if (fast) {
            { int tid = tid_in, lane = lane_in; asm volatile("" : "+v"(tid), "+v"(lane));
              const int r32 = lane & 31, hi = lane >> 5;
              if (tid < 32) ((LAS unsigned*)(lds + CCNT_OFF))[tid] = 0u;
              AT_BAR();
              const unsigned T22 = MISC[128 + 2 * r32];
              const int nhalf = 2 * ((ntile - wave + NWAVES - 1) / NWAVES);
              GAS u32x4* kcw = (GAS u32x4*)kc + (size_t)(wave * 16) * 256 + lane;
              u32x4 kq[4], kqn[4];
              if (nhalf > 0) {
#pragma unroll
                  for (int r4 = 0; r4 < 4; ++r4) kq[r4] = kcw[r4 * 64]; }
              unsigned gm0 = 0u, em0 = 0u;
#pragma unroll 1
              for (int i = 0; i < nhalf; ++i) {
                  const int t = wave + 8 * (i >> 1), sh = i & 1;
                  if (i + 1 < nhalf) {
#pragma unroll
                      for (int r4 = 0; r4 < 4; ++r4) kqn[r4] = kcw[((i + 1) * 4 + r4) * 64]; }
                  unsigned g_ = 0u, e_ = 0u;
#pragma unroll
                  for (int r = 0; r < 16; ++r) { const unsigned key = kq[r >> 2][r & 3], bn = key >> 10;
                      g_ |= (bn > T22) ? (1u << ((r & 3) + 8 * (r >> 2))) : 0u;
                      if (bn == T22) { const unsigned slot = __hip_atomic_fetch_add((LAS unsigned*)(lds + CCNT_OFF) + r32, 1u, __ATOMIC_RELAXED, __HIP_MEMORY_SCOPE_WORKGROUP);
                          if (slot < 16u) *(LAS u32x2*)(lds + CAND_OFF + (r32 * 16 + slot) * 8) = (u32x2){key, (unsigned)(64 * t + 32 * sh + (r & 3) + 8 * (r >> 2) + 4 * hi)}; } }
                  if (sh == 0) { gm0 = g_; em0 = e_; }
                  else { unsigned glo = gm0 << (4 * hi), ghi = g_ << (4 * hi), elo = em0 << (4 * hi), ehi = e_ << (4 * hi);
                      glo |= __shfl_xor(glo, 32); ghi |= __shfl_xor(ghi, 32); elo |= __shfl_xor(elo, 32); ehi |= __shfl_xor(ehi, 32);
                      if (hi == 0) { *(LAS u32x2*)(lds + GT_OFF + (r32 * 64 + t) * 8) = (u32x2){glo, ghi}; *(LAS u32x2*)(lds + EQ_OFF + (r32 * 64 + t) * 8) = (u32x2){elo, ehi}; } }
#pragma unroll
                  for (int r4 = 0; r4 < 4; ++r4) kq[r4] = kqn[r4];
              } }
            AT_BAR();
            { int tid = tid_in; asm volatile("" : "+v"(tid)); const int q = tid >> 4, j = tid & 15;
              const unsigned c0 = MISC[192 + q], need = MISC[129 + 2 * q];
              if ((unsigned)j < c0) { const u32x2 my = *(const LAS u32x2*)(lds + CAND_OFF + (q * 16 + j) * 8); unsigned rank = 0;
#pragma unroll 1
                  for (unsigned i = 0; i < c0; ++i) { const u32x2 ot = *(const LAS u32x2*)(lds + CAND_OFF + (q * 16 + i) * 8); rank += (ot.x > my.x || (ot.x == my.x && ot.y < my.y)) ? 1u : 0u; }
                  if (rank < need) (void)__hip_atomic_fetch_or((LAS unsigned*)(lds + GT_OFF + (q * 64 + (my.y >> 6)) * 8 + 4 * ((my.y >> 5) & 1u)), 1u << (my.y & 31u), __ATOMIC_RELAXED, __HIP_MEMORY_SCOPE_WORKGROUP); } }
            AT_BAR();
        }
#undef BM_SCAN
        { int tid = tid_in; asm volatile("" : "+v"(tid)); const int q = tid >> 4, j = tid & 15; const unsigned need_eq = fast ? 0u : MISC[129 + 2 * q];
          unsigned long long g[4], e[4]; unsigned ce = 0;
#pragma unroll
          for (int i = 0; i < 4; ++i) { const int t = 4 * j + i; g[i] = 0ull; e[i] = 0ull;
              if (t < ntile) { const u32x2 a = *(const LAS u32x2*)(lds + GT_OFF + (q * 64 + t) * 8), c = *(const LAS u32x2*)(lds + EQ_OFF + (q * 64 + t) * 8);
                  g[i] = ((unsigned long long)a.y << 32) | a.x; e[i] = ((unsigned long long)c.y << 32) | c.x; }
              ce += (unsigned)__builtin_popcountll(e[i]); }
          unsigned cum = ce;
#pragma unroll
          for (int off = 1; off < 16; off <<= 1) { const unsigned tt = __shfl_up(cum, off, 16); if (j >= off) cum += tt; }
          int allowed = (int)need_eq - (int)(cum - ce);
          unsigned cs = 0;
#pragma unroll
          for (int i = 0; i < 4; ++i) { unsigned long long x = e[i]; const int pc = __builtin_popcountll(x);
              if (allowed <= 0) x = 0ull; else if (pc > allowed) { int drop = pc - allowed; while (drop > 0) { x &= ~(1ull << (63 - __builtin_clzll(x))); --drop; } }
              allowed -= pc; g[i] |= x; cs += (unsigned)__builtin_popcountll(g[i]); }
          unsigned cum2 = cs;
#pragma unroll
          for (int off = 1; off < 16; off <<= 1) { const unsigned tt = __shfl_up(cum2, off, 16); if (j >= off) cum2 += tt; }
          unsigned pos = cum2 - cs;
          LAS unsigned short* sq = sel + q * 256;
#pragma unroll
          for (int i = 0; i < 4; ++i) { unsigned long long x = g[i]; const int t = 4 * j + i;
              while (x) { const int bpos = __builtin_ctzll(x); x &= x - 1; if (pos < 256u) sq[pos] = (unsigned short)(64 * t + bpos); ++pos; } } }
    } else {
        for (int i = tid_in; i < 32 * 256; i += NWAVES * 64) { const int k = i & 255; sel[i] = (unsigned short)(k < nk ? k : 0); }
    }
    AT_BAR();
    int lane = lane_in; asm volatile("" : "+v"(lane));
    const int c = lane & 15, g = lane >> 4;
    const LAS bf16_t* tabB = (const LAS bf16_t*)(lds + TAB_OFF);
    const unsigned lds0 = (unsigned)(uintptr_t)lds;
    LAS unsigned char* vimg = lds + VIMG_OFF + wave * 12288;
    const unsigned vdst = (unsigned)__builtin_amdgcn_readfirstlane(lds0 + VIMG_OFF + wave * 12288);
    const bf16_t* kvb = PROJ + rowbase * AB_INP + 2048;
    const LAS unsigned short* selw = sel + (4 * wave) * 256;
#define BM_KLOAD(dst, s_) do { const int e_ = 32 * (s_) + c; const int k0_ = selw[e_], k1_ = selw[e_ + 16]; \
        const bf16_t* p0_ = kvb + (size_t)k0_ * AB_INP + 8 * g; const bf16_t* p1_ = kvb + (size_t)k1_ * AB_INP + 8 * g; \
        dst[0] = *(const GAS bf16x8*)p0_; dst[1] = *(const GAS bf16x8*)(p0_ + 32); dst[2] = *(const GAS bf16x8*)p1_; dst[3] = *(const GAS bf16x8*)(p1_ + 32); } while (0)
#define BM_VDMA(s_) do { _Pragma("unroll") for (int n_ = 0; n_ < 4; ++n_) { const int kidx_ = selw[32 * (s_) + 8 * n_ + (lane >> 3)]; \
        glds16(kvb + (size_t)kidx_ * AB_INP + 64 + 8 * (lane & 7), vdst + ((s_) % 3) * 4096 + n_ * 1024); } } while (0)
    bf16x8 kr[4][4];
    BM_KLOAD(kr[0], 0); BM_KLOAD(kr[1], 1); BM_KLOAD(kr[2], 2); BM_KLOAD(kr[3], 3);
    BM_VDMA(0); BM_VDMA(1);
    bf16x8 qb0 = (bf16x8){}, qb1 = (bf16x8){};
    float mh = 0.f, l = 0.f;
    f32x4 o[4] = {(f32x4){0.f, 0.f, 0.f, 0.f}, (f32x4){0.f, 0.f, 0.f, 0.f}, (f32x4){0.f, 0.f, 0.f, 0.f}, (f32x4){0.f, 0.f, 0.f, 0.f}};
#pragma unroll 1
    for (int s0 = 0; s0 < 32; s0 += 4) {
#pragma unroll
        for (int u = 0; u < 4; ++u) {
            const int s = s0 + u, qi = s >> 3, ch = s & 7, q = q0 + 4 * wave + qi;
            const bool first = (ch == 0);
            if (first) {
                qb0 = (bf16x8){}; qb1 = (bf16x8){};
                if (c < 8) { const bf16_t* qp = PROJ + (rowbase + q) * AB_INP + 1536 + c * 64 + 8 * g; qb0 = *(const GAS bf16x8*)qp; qb1 = *(const GAS bf16x8*)(qp + 32); }
                mh = 0.f; l = 0.f;
#pragma unroll
                for (int nt = 0; nt < 4; ++nt) o[nt] = (f32x4){0.f, 0.f, 0.f, 0.f};
            }
            if (s + 2 < 32) BM_VDMA(s + 2);
            f32x4 sa = (f32x4){0.f, 0.f, 0.f, 0.f}, sb = (f32x4){0.f, 0.f, 0.f, 0.f};
            sa = __builtin_amdgcn_mfma_f32_16x16x32_bf16(kr[u][0], qb0, sa, 0, 0, 0); sa = __builtin_amdgcn_mfma_f32_16x16x32_bf16(kr[u][1], qb1, sa, 0, 0, 0);
            sb = __builtin_amdgcn_mfma_f32_16x16x32_bf16(kr[u][2], qb0, sb, 0, 0, 0); sb = __builtin_amdgcn_mfma_f32_16x16x32_bf16(kr[u][3], qb1, sb, 0, 0, 0);
            if (s + 4 < 32) BM_KLOAD(kr[u], s + 4);
            const u32x2 wa = *(const LAS u32x2*)(selw + 32 * s + 4 * g), wb = *(const LAS u32x2*)(selw + 32 * s + 16 + 4 * g);
            const int ka[4] = {(int)(wa.x & 0xffffu), (int)(wa.x >> 16), (int)(wa.y & 0xffffu), (int)(wa.y >> 16)}, kb4[4] = {(int)(wb.x & 0xffffu), (int)(wb.x >> 16), (int)(wb.y & 0xffffu), (int)(wb.y >> 16)};
            float lm = -1e30f;
#pragma unroll
            for (int i = 0; i < 4; ++i) {
                int da = q - ka[i]; da = da > 559 ? 559 : da; int db = q - kb4[i]; db = db > 559 ? 559 : db;
                const float va = (32 * ch + 4 * g + i < ns) ? sa[i] + bf2f(tabB[(da + 63) * 8 + (c & 7)]) - mh : -1e30f;
                const float vb2 = (32 * ch + 16 + 4 * g + i < ns) ? sb[i] + bf2f(tabB[(db + 63) * 8 + (c & 7)]) - mh : -1e30f;
                sa[i] = va; sb[i] = vb2; lm = fmaxf(lm, fmaxf(va, vb2)); }
            if (first || __any(lm > 8.f)) {
                float rm = fmaxf(lm, __shfl_xor(lm, 16)); rm = fmaxf(rm, __shfl_xor(rm, 32));
                const float dl = first ? rm : fmaxf(rm, 0.f);
                mh += dl;
#pragma unroll
                for (int i = 0; i < 4; ++i) { sa[i] -= dl; sb[i] -= dl; }
                if (!first) { const float f = __builtin_amdgcn_exp2f(-dl); l *= f;
#pragma unroll
                    for (int i = 0; i < 4; ++i) { const float fi = __shfl(f, 4 * g + i);
#pragma unroll
                        for (int nt = 0; nt < 4; ++nt) o[nt][i] *= fi; } }
            }
#pragma unroll
            for (int i = 0; i < 4; ++i) { sa[i] = __builtin_amdgcn_exp2f(sa[i]); sb[i] = __builtin_amdgcn_exp2f(sb[i]); l += sa[i] + sb[i]; }
            const u32x4 pw = (u32x4){cvtpk(sa[0], sa[1]), cvtpk(sa[2], sa[3]), cvtpk(sb[0], sb[1]), cvtpk(sb[2], sb[3])};
            if (s0 != 28 || u == 0) asm volatile("s_waitcnt vmcnt(16)" ::: "memory");
            else if (u == 1) asm volatile("s_waitcnt vmcnt(12)" ::: "memory");
            else if (u == 2) asm volatile("s_waitcnt vmcnt(4)" ::: "memory");
            else asm volatile("s_waitcnt vmcnt(0)" ::: "memory");
            lds_cptr vb = (lds_cptr)vimg + (s % 3) * 4096 + (4 * g + (c >> 2)) * 128 + 8 * (c & 3);
#pragma unroll
            for (int nt = 0; nt < 4; ++nt) { const s16x4 lo = vtr(vb + 32 * nt), hi4 = vtr(vb + 16 * 128 + 32 * nt);
                const bf16x8 vf = (bf16x8){lo[0], lo[1], lo[2], lo[3], hi4[0], hi4[1], hi4[2], hi4[3]};
                o[nt] = __builtin_amdgcn_mfma_f32_16x16x32_bf16(__builtin_bit_cast(bf16x8, pw), vf, o[nt], 0, 0, 0); }
            LDS_WAIT();
            if (ch == 7) {
                float lt = l + __shfl_xor(l, 16); lt += __shfl_xor(lt, 32);
                const float linv = __builtin_amdgcn_rcpf(lt);
                if (g < 2) { bf16_t* op = ATT + (rowbase + q) * D + 512 + c;
#pragma unroll
                    for (int i = 0; i < 4; ++i) { const float li = __shfl(linv, 4 * g + i);
#pragma unroll
                        for (int nt = 0; nt < 4; ++nt) op[(4 * g + i) * 64 + 16 * nt] = (bf16_t)f2bf(o[nt][i] * li); } }
            }
        }
    }
    asm volatile("s_waitcnt vmcnt(0)" ::: "memory");
#undef BM_KLOAD
#undef BM_VDMA
}
}
__device__ __forceinline__ void attn_b_phase(LAS unsigned char* lds, volatile LAS unsigned* MISC, const bf16_t* PROJ, const float* t5, bf16_t* ATT, unsigned* kc, int vcu, int G, int wave, int lane, int tid) {
    AT_BAR();
    { LAS bf16_t* tab = (LAS bf16_t*)(lds + TAB_OFF);
      for (int i = tid; i < 640 * 8; i += NWAVES * 64) { const int idx = i >> 3, h = i & 7; const int d = idx - 63; tab[i] = (bf16_t)f2bf(t5[t5_bucket(-d) * 12 + 4 + h] * LOG2E); } }
    AT_BAR();
    for (int p = vcu; p < 512; p += G) {
        const int b = p >> 6, s = p & 63;
#pragma unroll 1
        for (int k = 0; k < 2; ++k) bm::unit(lds, MISC, PROJ, ATT, kc, b, k ? 127 - s : s, wave, lane, tid);
    }
}
namespace nv {
constexpr int CW_TB = 256;
__device__ __forceinline__ float ldbf(const bf16_t* p) { return bf2f(*p); }
__device__ __forceinline__ bf16_t tobf(float f) { return (bf16_t)f2bf(f); }

template <bool ADDY, bool WXN, bool WSUM, bool WNORM> __global__ void nk_rows(RowIO io, int rows) {
    int row = blockIdx.x * 4 + (threadIdx.x >> 6), lane = threadIdx.x & 63;
    if (row >= rows) return;
    rms_row<ADDY, WXN, WSUM, WNORM>(io, row, lane);
}
__global__ void nk_ssq(const float* h, float* ssq) {
    int row = blockIdx.x * 4 + (threadIdx.x >> 6), lane = threadIdx.x & 63;
    const float4* xr = (const float4*)(h + (size_t)row * D); float s = 0.f;
    for (int j = 0; j < 4; ++j) { float4 v = xr[lane + 64 * j]; s += v.x * v.x + v.y * v.y + v.z * v.z + v.w * v.w; }
    s = wave_sum(s);
    if (lane < 16) ssq[(size_t)row * 16 + lane] = lane == 0 ? s : 0.f;
}
__global__ void nk_lam(const float* lam, float* out) {
    int l = threadIdx.x;
    float a = wave_sum(lam[l] * lam[64 + l]), b = wave_sum(lam[128 + l] * lam[192 + l]);
    if (l == 0) out[0] = expf(a) - expf(b) + 0.2f;
}
template <int MODE>
__global__ void __launch_bounds__(256) nk_gemm(const bf16_t* A, int lda, const float* B, int ldb, int M, int N, int K, bf16_t* Cb, int ldc, int s0, int s1, int s2, int s3,
                                               const float* R, float* out, const bf16_t* Y0, const bf16_t* Y1) {
    __shared__ float As[16][68];
    __shared__ float Bs[16][68];
    const int tid = threadIdx.x, tx = tid & 15, ty = tid >> 4;
    const int m0 = blockIdx.y * 64, n0 = blockIdx.x * 64;
    float acc[4][4];
#pragma unroll
    for (int i = 0; i < 4; ++i)
#pragma unroll
        for (int j = 0; j < 4; ++j) acc[i][j] = 0.f;
    const int ar = tid >> 2, ac = (tid & 3) * 4, br = tid >> 4, bc = (tid & 15) * 4;
    for (int k0 = 0; k0 < K; k0 += 16) {
        const bf16_t* ap = A + (size_t)(m0 + ar) * lda + k0 + ac;
        float4 av = make_float4(ldbf(ap), ldbf(ap + 1), ldbf(ap + 2), ldbf(ap + 3));
        float4 bv = make_float4(0.f, 0.f, 0.f, 0.f);
        if (n0 + bc < N) bv = *(const float4*)(B + (size_t)(k0 + br) * ldb + n0 + bc);
        __syncthreads();
        As[ac + 0][ar] = av.x; As[ac + 1][ar] = av.y; As[ac + 2][ar] = av.z; As[ac + 3][ar] = av.w;
        *(float4*)&Bs[br][bc] = bv;
        __syncthreads();
#pragma unroll
        for (int k = 0; k < 16; ++k) {
            float4 a4 = *(const float4*)&As[k][ty * 4]; float4 b4 = *(const float4*)&Bs[k][tx * 4];
            float a[4] = {a4.x, a4.y, a4.z, a4.w}, b[4] = {b4.x, b4.y, b4.z, b4.w};
#pragma unroll
            for (int i = 0; i < 4; ++i)
#pragma unroll
                for (int j = 0; j < 4; ++j) acc[i][j] += a[i] * b[j];
        }
    }
#pragma unroll
    for (int i = 0; i < 4; ++i) {
        const int r = m0 + ty * 4 + i;
#pragma unroll
        for (int j = 0; j < 4; ++j) { const int c = n0 + tx * 4 + j;
            if (MODE == 0) { if (c < ldc) { float v = (c < N) ? acc[i][j] : 0.f; if ((c >= s0 && c < s1) || (c >= s2 && c < s3)) v *= QSCALE; Cb[(size_t)r * ldc + c] = tobf(v); } }
            else { const size_t o = (size_t)r * D + c; float v = R[o] + acc[i][j]; if (MODE == 2) v += ldbf(Y0 + o) + ldbf(Y1 + o); out[o] = v; } }
    }
}

__device__ __forceinline__ float block_reduce(float v, float* scr, bool is_max) {
    const int tid = threadIdx.x, nw = blockDim.x >> 6;
    v = is_max ? wave_max(v) : wave_sum(v);
    __syncthreads();
    if ((tid & 63) == 0) scr[tid >> 6] = v;
    __syncthreads();
    float r = scr[0];
    for (int i = 1; i < nw; ++i) r = is_max ? fmaxf(r, scr[i]) : r + scr[i];
    return r;
}
__global__ void __launch_bounds__(256) nk_attn_a(const bf16_t* proj, const float* t5, const float* lamf, const float* subln, bf16_t* y) {
    __shared__ float q0[64], q1[64], s0[4096], s1[4096], scr[8], part[128];
    const int tid = threadIdx.x;
    const int q = blockIdx.x, h = blockIdx.y, b = blockIdx.z;
    const bf16_t* prow = proj + (size_t)(b * SEQ + q) * AB_INP;
    if (tid < 64) q0[tid] = ldbf(prow + h * 128 + tid); else if (tid < 128) q1[tid - 64] = ldbf(prow + h * 128 + tid);
    __syncthreads();
    const int nk = 64 * (q / 64 + 1);
    float m0 = -1e30f, m1 = -1e30f;
    for (int k = tid; k < nk; k += 256) {
        const bf16_t* kr = proj + (size_t)(b * SEQ + k) * AB_INP + 512 + h * 128;
        float d0 = 0.f, d1 = 0.f;
#pragma unroll 8
        for (int d = 0; d < 64; ++d) { d0 += q0[d] * ldbf(kr + d); d1 += q1[d] * ldbf(kr + 64 + d); }
        float bias = t5[t5_bucket(k - q) * 12 + h] * LOG2E;
        d0 += bias; d1 += bias;
        s0[k] = d0; s1[k] = d1; m0 = fmaxf(m0, d0); m1 = fmaxf(m1, d1);
    }
    m0 = block_reduce(m0, scr, true); m1 = block_reduce(m1, scr, true);
    float l0 = 0.f, l1 = 0.f;
    for (int k = tid; k < nk; k += 256) { float e0 = exp2f(s0[k] - m0), e1 = exp2f(s1[k] - m1); s0[k] = e0; s1[k] = e1; l0 += e0; l1 += e1; }
    l0 = block_reduce(l0, scr, false); l1 = block_reduce(l1, scr, false);
    const float lam = lamf[0];
    const float c0 = 1.f / l0, c1 = lam / l1;
    for (int k = tid; k < nk; k += 256) s0[k] = s0[k] * c0 - s1[k] * c1;
    __syncthreads();
    const int e = tid & 127, half = tid >> 7;
    float o = 0.f;
    const bf16_t* vb = proj + (size_t)(b * SEQ) * AB_INP + 1024 + h * 128 + e;
    for (int k = half; k < nk; k += 2) o += s0[k] * ldbf(vb + (size_t)k * AB_INP);
    if (half == 1) part[e] = o;
    __syncthreads();
    if (half == 0) o += part[e];
    float ss = (half == 0) ? o * o : 0.f;
    ss = block_reduce(ss, scr, false);
    if (half == 0) y[(size_t)(b * SEQ + q) * D + h * 128 + e] = tobf(o * rsqrtf(ss * (1.f / 128.f) + EPS) * subln[e] * 0.8f);
}
__device__ __forceinline__ unsigned sortable(float f) { unsigned u = __float_as_uint(f); return (u & 0x80000000u) ? ~u : (u | 0x80000000u); }
__global__ void __launch_bounds__(256) nk_mixer_b(const bf16_t* proj, const float* t5, bf16_t* y) {
    __shared__ float qi[256], wi[4], qb[512], sc[8 * 256];
    __shared__ unsigned keys[4096];
    __shared__ int sel[256], scan[257], ired[8];
    const int tid = threadIdx.x;
    const int q = blockIdx.x, b = blockIdx.y;
    const bf16_t* prow = proj + (size_t)(b * SEQ + q) * AB_INP;
    qi[tid] = ldbf(prow + 2176 + tid); qb[tid] = ldbf(prow + 1536 + tid); qb[256 + tid] = ldbf(prow + 1536 + 256 + tid);
    if (tid < 4) wi[tid] = ldbf(prow + 2496 + tid) * 0.0625f;
    __syncthreads();
    const int nk = 64 * (q / 64 + 1);
    for (int k = tid; k < nk; k += 256) {
        const bf16_t* kr = proj + (size_t)(b * SEQ + k) * AB_INP + 2432;
        float isc = 0.f;
#pragma unroll 1
        for (int hh = 0; hh < 4; ++hh) { float dsum = 0.f;
#pragma unroll 8
            for (int d = 0; d < 64; ++d) dsum += qi[hh * 64 + d] * ldbf(kr + d);
            isc += fmaxf(dsum, 0.f) * wi[hh]; }
        keys[k] = sortable(isc + 0.f);
    }
    __syncthreads();
    int ns;
    if (nk <= 256) { if (tid < nk) sel[tid] = tid; ns = nk; __syncthreads(); }
    else {
        unsigned prefix = 0u; int need = 256;
        for (int bit = 31; bit >= 0; --bit) {
            const unsigned hmask = (bit == 31) ? 0u : (0xFFFFFFFFu << (bit + 1));
            int c = 0;
            for (int k = tid; k < nk; k += 256) { unsigned kk = keys[k]; c += (((kk & hmask) == prefix) && ((kk >> bit) & 1u)) ? 1 : 0; }
#pragma unroll
            for (int o = 1; o < 64; o <<= 1) c += __shfl_xor(c, o);
            __syncthreads();
            if ((tid & 63) == 0) ired[tid >> 6] = c;
            __syncthreads();
            c = ired[0] + ired[1] + ired[2] + ired[3];
            if (c >= need) prefix |= (1u << bit); else need -= c;
        }
        const unsigned T = prefix;
        const int k0 = tid * 16;
        int ceq = 0;
        for (int k = k0; k < k0 + 16 && k < nk; ++k) ceq += (keys[k] == T);
        __syncthreads();
        scan[tid] = ceq;
        __syncthreads();
        if (tid == 0) { int a = 0; for (int i = 0; i < 256; ++i) { int t = scan[i]; scan[i] = a; a += t; } }
        __syncthreads();
        int rank = scan[tid];
        unsigned flags = 0u; int cs = 0;
        for (int k = k0; k < k0 + 16 && k < nk; ++k) {
            unsigned kk = keys[k]; bool s = kk > T;
            if (kk == T) { s = rank < need; ++rank; }
            if (s) { flags |= 1u << (k - k0); ++cs; }
        }
        __syncthreads();
        scan[tid] = cs;
        __syncthreads();
        if (tid == 0) { int a = 0; for (int i = 0; i < 256; ++i) { int t = scan[i]; scan[i] = a; a += t; } scan[256] = a; }
        __syncthreads();
        int pos = scan[tid];
        for (int i = 0; i < 16; ++i) if (flags & (1u << i)) { if (pos < 256) sel[pos] = k0 + i; ++pos; }
        ns = scan[256] < 256 ? scan[256] : 256;
        __syncthreads();
    }
    const int h = tid >> 5, jl = tid & 31;
    float mx = -1e30f;
    for (int j = jl; j < ns; j += 32) {
        const int kidx = sel[j];
        const bf16_t* kr = proj + (size_t)(b * SEQ + kidx) * AB_INP + 2048;
        float dsum = 0.f;
#pragma unroll 8
        for (int d = 0; d < 64; ++d) dsum += qb[h * 64 + d] * ldbf(kr + d);
        dsum += t5[t5_bucket(kidx - q) * 12 + 4 + h] * LOG2E;
        sc[h * 256 + j] = dsum; mx = fmaxf(mx, dsum);
    }
#pragma unroll
    for (int o = 1; o < 32; o <<= 1) mx = fmaxf(mx, __shfl_xor(mx, o));
    float l = 0.f;
    for (int j = jl; j < ns; j += 32) { float e = exp2f(sc[h * 256 + j] - mx); sc[h * 256 + j] = e; l += e; }
#pragma unroll
    for (int o = 1; o < 32; o <<= 1) l += __shfl_xor(l, o);
    __syncthreads();
    const float inv = 1.f / l;
    float o0 = 0.f, o1 = 0.f;
    for (int j = 0; j < ns; ++j) {
        const bf16_t* vr = proj + (size_t)(b * SEQ + sel[j]) * AB_INP + 2112;
        const float p = sc[h * 256 + j];
        o0 += p * ldbf(vr + jl); o1 += p * ldbf(vr + jl + 32);
    }
    bf16_t* yr = y + (size_t)(b * SEQ + q) * D + 512 + h * 64;
    yr[jl] = tobf(o0 * inv); yr[jl + 32] = tobf(o1 * inv);
}
__global__ void __launch_bounds__(128) nk_attn_c(const bf16_t* qkv, const float* rel, bf16_t* y) {
    __shared__ float qs[64], s[576], scr[8], part[64];
    const int tid = threadIdx.x;
    const int q = blockIdx.x, h = blockIdx.y, b = blockIdx.z;
    if (tid < 64) qs[tid] = ldbf(qkv + (size_t)(b * SEQ + q) * C_IN + h * 64 + tid);
    __syncthreads();
    const int c = q / 64, kstart = c * 64 - 512;
    float mx = -1e30f;
    for (int j = tid; j < 576; j += 128) {
        const int kp = kstart + j;
        float v = -1e30f;
        if (kp >= 0) {
            const bf16_t* kr = qkv + (size_t)(b * SEQ + kp) * C_IN + 1024 + h * 64;
            float dsum = 0.f;
#pragma unroll 8
            for (int d = 0; d < 64; ++d) dsum += qs[d] * ldbf(kr + d);
            int r = q - kp; r = r < -128 ? -128 : (r > 128 ? 128 : r);
            v = dsum + rel[(r + 128) * 16 + h] * LOG2E;
        }
        s[j] = v; mx = fmaxf(mx, v);
    }
    mx = block_reduce(mx, scr, true);
    float l = 0.f;
    for (int j = tid; j < 576; j += 128) { float e = (kstart + j >= 0) ? exp2f(s[j] - mx) : 0.f; s[j] = e; l += e; }
    l = block_reduce(l, scr, false);
    __syncthreads();
    const int d = tid & 63, half = tid >> 6;
    float o = 0.f;
    for (int j = half; j < 576; j += 2) { const int kp = kstart + j; if (kp >= 0) o += s[j] * ldbf(qkv + (size_t)(b * SEQ + kp) * C_IN + 2048 + h * 64 + d); }
    if (half == 1) part[d] = o;
    __syncthreads();
    if (half == 0) y[(size_t)(b * SEQ + q) * D + h * 64 + d] = tobf((o + part[d]) / l);
}
__global__ void __launch_bounds__(64) nk_router(const float* hbuf, const float* g, const float* wrg, const float* brg, const float* wre, const float* bre,
                                                bf16_t* xn, unsigned* cnt, int* list, float* lw) {
    __shared__ float xs[D]; __shared__ float lg[36];
    const int t = blockIdx.x, lane = threadIdx.x;
    const float4* xr = (const float4*)(hbuf + (size_t)t * D);
    float4 v[4]; float s = 0.f;
#pragma unroll
    for (int j = 0; j < 4; ++j) { v[j] = xr[lane + 64 * j]; s += v[j].x * v[j].x + v[j].y * v[j].y + v[j].z * v[j].z + v[j].w * v[j].w; }
    s = wave_sum(s);
    const float r = rsqrtf(s * (1.f / D) + EPS);
    const float4* gg = (const float4*)g;
#pragma unroll
    for (int j = 0; j < 4; ++j) { float4 gv = gg[lane + 64 * j]; float4 w; w.x = v[j].x * r * gv.x; w.y = v[j].y * r * gv.y; w.z = v[j].z * r * gv.z; w.w = v[j].w * r * gv.w; ((float4*)xs)[lane + 64 * j] = w;
        u32x2 o; o.x = pk2(w.x, w.y); o.y = pk2(w.z, w.w); ((u32x2*)(xn + (size_t)t * D))[lane + 64 * j] = o; }
    __syncthreads();
    if (lane < 36) {
        float a = 0.f;
        if (lane < 4) { for (int k = 0; k < D; ++k) a += xs[k] * wrg[k * 4 + lane]; a += brg[lane]; }
        else { const int e = lane - 4; for (int k = 0; k < D; ++k) a += xs[k] * wre[k * 32 + e]; a += bre[e]; }
        lg[lane] = a;
    }
    __syncthreads();
    if (lane == 0) {
        int gs = 0; float gm = lg[0];
        for (int i = 1; i < 4; ++i) if (lg[i] > gm) { gm = lg[i]; gs = i; }
        float gsum = 0.f; for (int i = 0; i < 4; ++i) gsum += expf(lg[i] - gm);
        const float pg = 1.f / gsum;
        const float* el = lg + 4 + gs * 8;
        float em = el[0]; for (int i = 1; i < 8; ++i) em = fmaxf(em, el[i]);
        float pe[8], esum = 0.f; for (int i = 0; i < 8; ++i) { pe[i] = expf(el[i] - em); esum += pe[i]; }
        for (int i = 0; i < 8; ++i) pe[i] /= esum;
        int i1 = 0; for (int i = 1; i < 8; ++i) if (pe[i] > pe[i1]) i1 = i;
        int i2 = (i1 == 0) ? 1 : 0; for (int i = 0; i < 8; ++i) if (i != i1 && pe[i] > pe[i2]) i2 = i;
        const float tw = pe[i1] + pe[i2];
        const float w1 = pe[i1] / tw * pg, w2 = pe[i2] / tw * pg;
        const int e1 = gs * 8 + i1, e2 = gs * 8 + i2;
        const int p1 = (int)atomicAdd(&cnt[e1], 1u), p2 = (int)atomicAdd(&cnt[e2], 1u);
        list[e1 * NTOK + p1] = t * 2; lw[e1 * NTOK + p1] = w1;
        list[e2 * NTOK + p2] = t * 2 + 1; lw[e2 * NTOK + p2] = w2;
    }
}
__global__ void nk_tiles(const unsigned* cnt, int* tb) { if (threadIdx.x == 0) { int a = 0; for (int e = 0; e < NEXP; ++e) { tb[e] = a; a += ((int)cnt[e] + 255) / 256; } tb[NEXP] = a; } }
__global__ void __launch_bounds__(256) nk_moe_gu(const bf16_t* xn, const float* Wg, const float* Wu, const unsigned* cnt, const int* tb, const int* list, bf16_t* H) {
    const int e = blockIdx.z, m0 = blockIdx.y * 64, n0 = blockIdx.x * 64;
    const int ce = (int)cnt[e];
    if (m0 >= ce) return;
    __shared__ float As[16][68], Bg[16][68], Bu[16][68];
    const int tid = threadIdx.x, tx = tid & 15, ty = tid >> 4;
    const int ar = tid >> 2, ac = (tid & 3) * 4, br = tid >> 4, bc = (tid & 15) * 4;
    const int arow = (m0 + ar < ce) ? (list[e * NTOK + m0 + ar] >> 1) : -1;
    const float* wg = Wg + (size_t)e * D * DEXP; const float* wu = Wu + (size_t)e * D * DEXP;
    float ag[4][4], au[4][4];
#pragma unroll
    for (int i = 0; i < 4; ++i)
#pragma unroll
        for (int j = 0; j < 4; ++j) { ag[i][j] = 0.f; au[i][j] = 0.f; }
    for (int k0 = 0; k0 < D; k0 += 16) {
        float4 av = make_float4(0.f, 0.f, 0.f, 0.f);
        if (arow >= 0) { const bf16_t* ap = xn + (size_t)arow * D + k0 + ac; av = make_float4(ldbf(ap), ldbf(ap + 1), ldbf(ap + 2), ldbf(ap + 3)); }
        float4 gv = *(const float4*)(wg + (size_t)(k0 + br) * DEXP + n0 + bc);
        float4 uv = *(const float4*)(wu + (size_t)(k0 + br) * DEXP + n0 + bc);
        __syncthreads();
        As[ac + 0][ar] = av.x; As[ac + 1][ar] = av.y; As[ac + 2][ar] = av.z; As[ac + 3][ar] = av.w;
        *(float4*)&Bg[br][bc] = gv; *(float4*)&Bu[br][bc] = uv;
        __syncthreads();
#pragma unroll
        for (int k = 0; k < 16; ++k) {
            float4 a4 = *(const float4*)&As[k][ty * 4]; float4 g4 = *(const float4*)&Bg[k][tx * 4]; float4 u4 = *(const float4*)&Bu[k][tx * 4];
            float a[4] = {a4.x, a4.y, a4.z, a4.w}, gg[4] = {g4.x, g4.y, g4.z, g4.w}, uu[4] = {u4.x, u4.y, u4.z, u4.w};
#pragma unroll
            for (int i = 0; i < 4; ++i)
#pragma unroll
                for (int j = 0; j < 4; ++j) { ag[i][j] += a[i] * gg[j]; au[i][j] += a[i] * uu[j]; }
        }
    }
    const int o0 = 256 * tb[e];
#pragma unroll
    for (int i = 0; i < 4; ++i) {
        const int r = m0 + ty * 4 + i;
        if (r < ce) {
#pragma unroll
            for (int j = 0; j < 4; ++j) H[(size_t)(o0 + r) * DEXP + n0 + tx * 4 + j] = tobf(ag[i][j] / (1.f + expf(-ag[i][j])) * au[i][j]);
        }
    }
}
__global__ void __launch_bounds__(256) nk_moe_d(const bf16_t* H, const float* Wd, const unsigned* cnt, const int* tb, const int* list, const float* lw, bf16_t* Y0, bf16_t* Y1) {
    const int e = blockIdx.z, m0 = blockIdx.y * 64, n0 = blockIdx.x * 64;
    const int ce = (int)cnt[e];
    if (m0 >= ce) return;
    __shared__ float As[16][68], Bs[16][68];
    const int tid = threadIdx.x, tx = tid & 15, ty = tid >> 4;
    const int ar = tid >> 2, ac = (tid & 3) * 4, br = tid >> 4, bc = (tid & 15) * 4;
    const int o0 = 256 * tb[e];
    const bool aok = (m0 + ar < ce);
    const float* wd = Wd + (size_t)e * DEXP * D;
    float acc[4][4];
#pragma unroll
    for (int i = 0; i < 4; ++i)
#pragma unroll
        for (int j = 0; j < 4; ++j) acc[i][j] = 0.f;
    for (int k0 = 0; k0 < DEXP; k0 += 16) {
        float4 av = make_float4(0.f, 0.f, 0.f, 0.f);
        if (aok) { const bf16_t* ap = H + (size_t)(o0 + m0 + ar) * DEXP + k0 + ac; av = make_float4(ldbf(ap), ldbf(ap + 1), ldbf(ap + 2), ldbf(ap + 3)); }
        float4 bv = *(const float4*)(wd + (size_t)(k0 + br) * D + n0 + bc);
        __syncthreads();
        As[ac + 0][ar] = av.x; As[ac + 1][ar] = av.y; As[ac + 2][ar] = av.z; As[ac + 3][ar] = av.w;
        *(float4*)&Bs[br][bc] = bv;
        __syncthreads();
#pragma unroll
        for (int k = 0; k < 16; ++k) {
            float4 a4 = *(const float4*)&As[k][ty * 4]; float4 b4 = *(const float4*)&Bs[k][tx * 4];
            float a[4] = {a4.x, a4.y, a4.z, a4.w}, bb[4] = {b4.x, b4.y, b4.z, b4.w};
#pragma unroll
            for (int i = 0; i < 4; ++i)
#pragma unroll
                for (int j = 0; j < 4; ++j) acc[i][j] += a[i] * bb[j];
        }
    }
#pragma unroll
    for (int i = 0; i < 4; ++i) {
        const int r = m0 + ty * 4 + i;
        if (r < ce) {
            const int ent = list[e * NTOK + r]; const float w = lw[e * NTOK + r];
            bf16_t* dst = ((ent & 1) ? Y1 : Y0) + (size_t)(ent >> 1) * D + n0 + tx * 4;
#pragma unroll
            for (int j = 0; j < 4; ++j) dst[j] = tobf(w * acc[i][j]);
        }
    }
}
}
#ifndef NAIVE_B
#define NAIVE_B 0
#endif
#ifndef XBAR
#define XBAR 0
#endif
#ifndef DUP
#define DUP 0
#endif
struct Args { const float* in[19]; float* out; unsigned char* ws; int ph_lo, ph_hi, li, pad; };
static_assert(sizeof(Args) == 19 * 8 + 8 + 8 + 16, "Args has no padding");

__global__ void __launch_bounds__(NWAVES * 64, 2) mk_fwd(Args args) {
    extern __shared__ __attribute__((aligned(16))) unsigned char lds_raw[];
    LAS unsigned char* lds = (LAS unsigned char*)lds_raw;
    volatile LAS unsigned* MISC = (volatile LAS unsigned*)(lds + MISC_OFF);
    const int tid = threadIdx.x, lane = tid & 63, wave = __builtin_amdgcn_readfirstlane(tid >> 6);
    const int G = gridDim.x; const int bx = blockIdx.x;
    const int vcu = (G % 8 == 0) ? (bx % 8) * (G / 8) + bx / 8 : bx;
    unsigned char* ws = args.ws;
    unsigned* ctl = (unsigned*)(ws + WS_CTL);
    const float* x = args.in[0]; const float* t5 = args.in[1]; const float* ln_mix = args.in[2]; const float* ln_ffn = args.in[3]; const float* ln_final = args.in[4];
    const float* ab_w_in = args.in[5]; const float* ab_w_out = args.in[6]; const float* dlam = args.in[7]; const float* subln = args.in[8];
    const float* c_w_in = args.in[9]; const float* c_w_out = args.in[10]; const float* c_rel = args.in[11];
    const float* w_rg = args.in[12]; const float* b_rg = args.in[13]; const float* w_re = args.in[14]; const float* b_re = args.in[15];
    const float* w_gate = args.in[16]; const float* w_up = args.in[17]; const float* w_down = args.in[18];
    float* hbuf = args.out;
    bf16_t* WIN0 = (bf16_t*)(ws + WS_WIN0); bf16_t* WOUT0 = (bf16_t*)(ws + WS_WOUT0); bf16_t* WCIN = (bf16_t*)(ws + WS_WCIN); bf16_t* WCOUT = (bf16_t*)(ws + WS_WCOUT);
    bf16_t* WGU = (bf16_t*)(ws + WS_WGU); bf16_t* WD = (bf16_t*)(ws + WS_WD); bf16_t* RW = (bf16_t*)(ws + WS_RW);
    bf16_t* XN = (bf16_t*)(ws + WS_XN); bf16_t* BIG = (bf16_t*)(ws + WS_BIG); bf16_t* HB = (bf16_t*)(ws + WS_H); bf16_t* Y0 = (bf16_t*)(ws + WS_Y0); bf16_t* Y1 = (bf16_t*)(ws + WS_Y1);
    float* SSQ = (float*)(ws + WS_SSQ); int* LIST = (int*)(ws + WS_LIST); float* LW = (float*)(ws + WS_LIST + 4 * MiB);

    for (int u = tid; u < 256; u += NWAVES * 64) MISC[u] = 0u;
    __syncthreads();
    const int lo = args.ph_lo, hi = args.ph_hi;
    XcdBarrier bar; bar.bar = ctl + CW_BAR + args.li * XCD_BAR_WORDS; bar.x = 0; bar.st = nullptr;
    if (hi - lo > 1) bar = xcd_barrier_post(ctl + CW_BAR + args.li * XCD_BAR_WORDS, MISC);
#define IN(k) (lo <= (k) && (k) < hi)
#define SEAM(k) do { if (IN(k) && IN((k) + 1)) { xcd_barrier(bar); for (int xb_ = 0; xb_ < XBAR; ++xb_) xcd_barrier(bar); } } while (0)
    const int gw = vcu * NWAVES + wave, NGW = G * NWAVES;


#define MOE_TILES(l) do { __syncthreads(); if (tid < NEXP) MISC[64 + tid] = __hip_atomic_load(ctl + CW_CNT + (l) * 32 + tid, __ATOMIC_RELAXED, __HIP_MEMORY_SCOPE_AGENT); __syncthreads(); \
        if (tid == 0) { int a_ = 0; for (int e_ = 0; e_ < NEXP; ++e_) { MISC[16 + e_] = (unsigned)a_; a_ += ((int)MISC[64 + e_] + 255) >> 8; } MISC[16 + NEXP] = (unsigned)a_; } __syncthreads(); } while (0)
#define MOE_LAYER(l, P) \
    if (IN(P)) { router_phase(lds, MISC, hbuf, SSQ, ln_ffn + (l) * D, RW + (size_t)(l) * 2 * 48 * D, b_rg + (l) * 4, b_re + (l) * 32, XN, ctl + CW_CNT + (l) * 32, LIST, LW, vcu, G, wave, lane, tid); } \
    SEAM(P); \
    if (IN((P) + 1)) { MOE_TILES(l); \
        pg8::MoeOrder<true> S{(const LAS int*)(lds + MISC_OFF + 64), (const LAS int*)(lds + MISC_OFF + 256), G, bx, 4, (int)MISC[16 + NEXP], 0u, (size_t)1024 * D * 2, (size_t)256 * D * 2, ((DUP & 16) && (l) == 0) ? 2 : 1}; \
        pg8::Gemm g{XN, WGU + (size_t)(l) * NEXP * 1024 * D, D, D, D, LIST}; pg8::EpiSwiglu E{HB}; \
        pg8::gemm_phase<pg8::EpiSwiglu, pg8::MoeOrder<true>>(lds + RING_OFF, g, S, E); } \
    SEAM((P) + 1); \
    if (IN((P) + 2)) { MOE_TILES(l); \
        pg8::MoeOrder<false> S{(const LAS int*)(lds + MISC_OFF + 64), (const LAS int*)(lds + MISC_OFF + 256), G, bx, 4, (int)MISC[16 + NEXP], (unsigned)(256 * DEXP * 2), (size_t)D * DEXP * 2, (size_t)256 * DEXP * 2, ((DUP & 32) && (l) == 0) ? 2 : 1}; \
        pg8::Gemm g{HB, WD + (size_t)(l) * NEXP * D * DEXP, DEXP, DEXP, DEXP, nullptr}; pg8::EpiScatter E{Y0, Y1, LIST, LW}; \
        pg8::gemm_phase<pg8::EpiScatter, pg8::MoeOrder<false>>(lds + RING_OFF, g, S, E); } \
    SEAM((P) + 2);

    if (IN(0)) for (int rep = 0; rep < ((DUP & 1) ? 2 : 1); ++rep) {
        LAS float* scr = (LAS float*)(lds + RING_OFF + wave * 16384);
        constexpr int I1 = 16 * 80, I2 = 16 * 32, I3 = 16 * 96, I4 = 16 * 32, IE = 768, NITEMS = I1 + I2 + I3 + I4 + 64 * IE;
        for (int it = gw; it < NITEMS; it += NGW) {
            int r = it;
            if (r < I1) { const int kb = r / 80, nb = r % 80, n0 = nb * 32; conv_item(ab_w_in, D, AB_IN, WIN0, kb * 64, n0, n0, (n0 < 512 || (n0 >= 1536 && n0 < 2048)) ? QSCALE : 1.f, scr, lane); continue; } r -= I1;
            if (r < I2) { const int kb = r / 32, nb = r % 32; conv_item(ab_w_out, D, D, WOUT0, kb * 64, nb * 32, nb * 32, 1.f, scr, lane); continue; } r -= I2;
            if (r < I3) { const int kb = r / 96, nb = r % 96, n0 = nb * 32; conv_item(c_w_in, D, C_IN, WCIN, kb * 64, n0, n0, n0 < 1024 ? QSCALE : 1.f, scr, lane); continue; } r -= I3;
            if (r < I4) { const int kb = r / 32, nb = r % 32; conv_item(c_w_out, D, D, WCOUT, kb * 64, nb * 32, nb * 32, 1.f, scr, lane); continue; } r -= I4;
            const int le = r / IE; r -= le * IE;
            if (r < 512) { const int up = r >> 8, q = r & 255, kb = q / 16, nb = q % 16, n0 = nb * 32;
                conv_item((up ? w_up : w_gate) + (size_t)le * D * DEXP, D, DEXP, WGU + (size_t)le * 1024 * D, kb * 64, n0, 256 * (n0 >> 7) + 128 * up + (n0 & 127), 1.f, scr, lane); }
            else { const int q = r - 512, kb = q / 32, nb = q % 32; conv_item(w_down + (size_t)le * DEXP * D, DEXP, D, WD + (size_t)le * D * DEXP, kb * 64, nb * 32, nb * 32, 1.f, scr, lane); }
        }
        for (int i = (vcu * NWAVES * 64 + tid); i < 2 * 48 * D; i += G * NWAVES * 64) {
            const int l = i / (48 * D), e = (i / D) % 48, k = i % D;
            float v = 0.f; if (e < 4) v = w_rg[(size_t)l * D * 4 + k * 4 + e]; else if (e < 36) v = w_re[(size_t)l * D * 32 + k * 32 + (e - 4)];
            const unsigned hb = f2bf(v); const float lof = v - __uint_as_float(hb << 16);
            RW[((size_t)(l * 2 + 0) * 48 + e) * D + k] = (bf16_t)hb; RW[((size_t)(l * 2 + 1) * 48 + e) * D + k] = (bf16_t)f2bf(lof);
        }
        if (bx == 0 && wave == 0) { const float a = wave_sum(dlam[lane] * dlam[64 + lane]), b = wave_sum(dlam[128 + lane] * dlam[192 + lane]); if (lane == 0) ((float*)ctl)[CW_LAM] = __expf(a) - __expf(b) + 0.2f; }
        RowIO io{x, nullptr, nullptr, ln_mix, XN, nullptr};
        for (int m = gw; m < NTOK; m += 2 * NGW) rms_row2<false, true, false, false>(io, m, m + NGW, lane);
    }
    SEAM(0);
    if (IN(1)) {
        pg8::Gemm g{XN, WIN0, D, D, D, nullptr}; pg8::DenseOrder S; S.init(NTOK, AB_INP, G, bx, D, D, (DUP & 2) ? 2 : 1);
        pg8::EpiBf16 E{BIG, AB_INP};
        pg8::gemm_phase<pg8::EpiBf16, pg8::DenseOrder>(lds + RING_OFF, g, S, E);
    }
    SEAM(1);
    if (IN(2)) {
        const float lamv = __hip_atomic_load((float*)ctl + CW_LAM, __ATOMIC_RELAXED, __HIP_MEMORY_SCOPE_AGENT);
        for (int rep = 0; rep < ((DUP & 4) ? 2 : 1); ++rep) attn_a_phase(lds, BIG, t5, subln, lamv, XN, vcu, G, wave, lane, tid);
        if (!NAIVE_B) for (int rep = 0; rep < ((DUP & 8) ? 2 : 1); ++rep) attn_b_phase(lds, MISC, BIG, t5, XN, (unsigned*)hbuf + (size_t)bx * 131072, vcu, G, wave, lane, tid);
    }
    SEAM(2);
    if (IN(3)) {
        pg8::Gemm g{XN, WOUT0, D, D, D, nullptr}; pg8::DenseOrder S; S.init(NTOK, D, G, bx, D, D, (DUP & 256) ? 2 : 1);
        pg8::EpiResid<false> E{x, hbuf, nullptr, nullptr, SSQ};
        pg8::gemm_phase<pg8::EpiResid<false>, pg8::DenseOrder, true>(lds + RING_OFF, g, S, E);
    }
    SEAM(3);
    MOE_LAYER(0, 4)
    if (IN(7)) {
        RowIO io{hbuf, Y0, Y1, ln_mix + D, XN, hbuf};
        for (int m = gw; m < NTOK; m += 2 * NGW) rms_row2<true, true, true, false>(io, m, m + NGW, lane);
    }
    SEAM(7);
    if (IN(8)) {
        pg8::Gemm g{XN, WCIN, D, D, D, nullptr}; pg8::DenseOrder S; S.init(NTOK, C_IN, G, bx, D, D, (DUP & 64) ? 2 : 1);
        pg8::EpiBf16 E{BIG, C_IN};
        pg8::gemm_phase<pg8::EpiBf16, pg8::DenseOrder>(lds + RING_OFF, g, S, E);
    }
    SEAM(8);
    if (IN(9)) for (int rep = 0; rep < ((DUP & 128) ? 2 : 1); ++rep) attn_c_phase(lds, BIG, c_rel, XN, vcu, G, wave, lane, tid);
    SEAM(9);
    if (IN(10)) {
        pg8::Gemm g{XN, WCOUT, D, D, D, nullptr}; pg8::DenseOrder S; S.init(NTOK, D, G, bx, D, D);
        pg8::EpiResid<false> E{hbuf, hbuf, nullptr, nullptr, SSQ};
        pg8::gemm_phase<pg8::EpiResid<false>, pg8::DenseOrder, true>(lds + RING_OFF, g, S, E);
    }
    SEAM(10);
    MOE_LAYER(1, 11)
    if (IN(14)) {
        if (DUP & 512) { RowIO iod{hbuf, Y0, Y1, ln_final, nullptr, (float*)XN}; for (int m = gw; m < NTOK; m += 2 * NGW) rms_row2<true, false, false, true>(iod, m, m + NGW, lane); }
        RowIO io{hbuf, Y0, Y1, ln_final, nullptr, hbuf};
        for (int m = gw; m < NTOK; m += 2 * NGW) rms_row2<true, false, false, true>(io, m, m + NGW, lane);
    }
#undef IN
#undef SEAM
}

#ifndef OPT_MASK
#define OPT_MASK 0x7FFF
#endif
extern "C" void kernel_launch(void* const* d_in, const int* in_sizes, int n_in, void* d_out, int out_size, void* d_ws, size_t ws_size, hipStream_t stream) {
    static int grid = 0;
    if (grid == 0) {
        if (n_in != 19 || ws_size < WS_END) { fprintf(stderr, "kernel_launch: unexpected n_in %d or ws_size %zu (< %zu)\n", n_in, ws_size, (size_t)WS_END); grid = -1; return; }
        int dev = 0, cus = 0, per_cu = 0;
        if (hipGetDevice(&dev) != hipSuccess || hipDeviceGetAttribute(&cus, hipDeviceAttributeMultiprocessorCount, dev) != hipSuccess) { grid = -1; return; }
        if (hipFuncSetAttribute((const void*)mk_fwd, hipFuncAttributeMaxDynamicSharedMemorySize, LDS_BYTES) != hipSuccess) { fprintf(stderr, "kernel_launch: hipFuncSetAttribute failed\n"); grid = -1; return; }
        if (hipOccupancyMaxActiveBlocksPerMultiprocessor(&per_cu, (const void*)mk_fwd, NWAVES * 64, LDS_BYTES) != hipSuccess || per_cu < 1) fprintf(stderr, "kernel_launch: occupancy query says %d\n", per_cu);
        (void)hipGetLastError();
        grid = cus;
    }
    if (grid < 0) return;
    const float* x = (const float*)d_in[0]; const float* t5 = (const float*)d_in[1]; const float* ln_mix = (const float*)d_in[2]; const float* ln_ffn = (const float*)d_in[3];
    const float* ln_final = (const float*)d_in[4]; const float* ab_w_in = (const float*)d_in[5]; const float* ab_w_out = (const float*)d_in[6]; const float* dlam = (const float*)d_in[7];
    const float* subln = (const float*)d_in[8]; const float* c_w_in = (const float*)d_in[9]; const float* c_w_out = (const float*)d_in[10]; const float* c_rel = (const float*)d_in[11];
    const float* w_rg = (const float*)d_in[12]; const float* b_rg = (const float*)d_in[13]; const float* w_re = (const float*)d_in[14]; const float* b_re = (const float*)d_in[15];
    const float* w_gate = (const float*)d_in[16]; const float* w_up = (const float*)d_in[17]; const float* w_down = (const float*)d_in[18];
    float* hbuf = (float*)d_out; unsigned char* ws = (unsigned char*)d_ws;
    unsigned* ctl = (unsigned*)(ws + WS_CTL); float* lamf = (float*)ctl + CW_LAM; int* tb = (int*)ctl + nv::CW_TB;
    bf16_t* XN = (bf16_t*)(ws + WS_XN); bf16_t* BIG = (bf16_t*)(ws + WS_BIG); bf16_t* HB = (bf16_t*)(ws + WS_H); bf16_t* Y0 = (bf16_t*)(ws + WS_Y0); bf16_t* Y1 = (bf16_t*)(ws + WS_Y1);
    float* SSQ = (float*)(ws + WS_SSQ); int* LIST = (int*)(ws + WS_LIST); float* LW = (float*)(ws + WS_LIST + 4 * MiB);
    (void)hipMemsetAsync(ws + WS_CTL, 0, CTL_ZERO_BYTES, stream);
    Args a{};
    for (int i = 0; i < 19; ++i) a.in[i] = (const float*)d_in[i];
    a.out = hbuf; a.ws = ws;
    int li = 0;
    for (int p = 0; p < NPHASE;) {
        if ((OPT_MASK >> p) & 1) {
            int q = p; while (q < NPHASE && ((OPT_MASK >> q) & 1)) { ++q; if (NAIVE_B && q == 3) break; }
            a.ph_lo = p; a.ph_hi = q; a.li = li++;
            hipLaunchKernelGGL(mk_fwd, dim3(grid), dim3(NWAVES * 64), LDS_BYTES, stream, a);
            if (NAIVE_B && q == 3) nv::nk_mixer_b<<<dim3(SEQ, BATCH), 256, 0, stream>>>(BIG, t5, XN);
            p = q; continue;
        }
        const int l = (p >= 11) ? 1 : 0;
        switch (p) {
        case 0: nv::nk_lam<<<1, 64, 0, stream>>>(dlam, lamf); { RowIO io{x, nullptr, nullptr, ln_mix, XN, nullptr}; nv::nk_rows<false, true, false, false><<<NTOK / 4, 256, 0, stream>>>(io, NTOK); } break;
        case 1: nv::nk_gemm<0><<<dim3(AB_INP / 64, NTOK / 64), 256, 0, stream>>>(XN, D, ab_w_in, AB_IN, NTOK, AB_IN, D, BIG, AB_INP, 0, 512, 1536, 2048, nullptr, nullptr, nullptr, nullptr); break;
        case 2: nv::nk_attn_a<<<dim3(SEQ, 4, BATCH), 256, 0, stream>>>(BIG, t5, lamf, subln, XN); nv::nk_mixer_b<<<dim3(SEQ, BATCH), 256, 0, stream>>>(BIG, t5, XN); break;
        case 3: nv::nk_gemm<1><<<dim3(D / 64, NTOK / 64), 256, 0, stream>>>(XN, D, ab_w_out, D, NTOK, D, D, nullptr, 0, 0, 0, 0, 0, x, hbuf, nullptr, nullptr); nv::nk_ssq<<<NTOK / 4, 256, 0, stream>>>(hbuf, SSQ); break;
        case 4: case 11: nv::nk_router<<<NTOK, 64, 0, stream>>>(hbuf, ln_ffn + l * D, w_rg + (size_t)l * D * 4, b_rg + l * 4, w_re + (size_t)l * D * 32, b_re + l * 32, XN, ctl + CW_CNT + l * 32, LIST, LW); break;
        case 5: case 12: nv::nk_tiles<<<1, 64, 0, stream>>>(ctl + CW_CNT + l * 32, tb);
            nv::nk_moe_gu<<<dim3(DEXP / 64, NTOK / 64, NEXP), 256, 0, stream>>>(XN, w_gate + (size_t)l * NEXP * D * DEXP, w_up + (size_t)l * NEXP * D * DEXP, ctl + CW_CNT + l * 32, tb, LIST, HB); break;
        case 6: case 13: nv::nk_tiles<<<1, 64, 0, stream>>>(ctl + CW_CNT + l * 32, tb);
            nv::nk_moe_d<<<dim3(D / 64, NTOK / 64, NEXP), 256, 0, stream>>>(HB, w_down + (size_t)l * NEXP * DEXP * D, ctl + CW_CNT + l * 32, tb, LIST, LW, Y0, Y1); break;
        case 7: { RowIO io{hbuf, Y0, Y1, ln_mix + D, XN, hbuf}; nv::nk_rows<true, true, true, false><<<NTOK / 4, 256, 0, stream>>>(io, NTOK); } break;
        case 8: nv::nk_gemm<0><<<dim3(C_IN / 64, NTOK / 64), 256, 0, stream>>>(XN, D, c_w_in, C_IN, NTOK, C_IN, D, BIG, C_IN, 0, 1024, 0, 0, nullptr, nullptr, nullptr, nullptr); break;
        case 9: nv::nk_attn_c<<<dim3(SEQ, 16, BATCH), 128, 0, stream>>>(BIG, c_rel, XN); break;
        case 10: nv::nk_gemm<1><<<dim3(D / 64, NTOK / 64), 256, 0, stream>>>(XN, D, c_w_out, D, NTOK, D, D, nullptr, 0, 0, 0, 0, 0, hbuf, hbuf, nullptr, nullptr); nv::nk_ssq<<<NTOK / 4, 256, 0, stream>>>(hbuf, SSQ); break;
        case 14: { RowIO io{hbuf, Y0, Y1, ln_final, nullptr, hbuf}; nv::nk_rows<true, false, false, true><<<NTOK / 4, 256, 0, stream>>>(io, NTOK); } break;
        }
        ++p;
    }
}
```

```cpp
#include <hip/hip_runtime.h>
#include <cstdio>
#include <cstdint>

constexpr int D = 1024, BATCH = 8, SEQ = 4096, NTOK = BATCH * SEQ;
constexpr int AB_IN = 2500, AB_INP = 2560, C_IN = 3072;
constexpr int NEXP = 32, DEXP = 512;
constexpr float EPS = 1e-6f;
constexpr float LOG2E = 1.4426950408889634f;
constexpr float QSCALE = 0.125f * LOG2E;
constexpr size_t MiB = 1u << 20;

#define GAS __attribute__((address_space(1)))
#define LAS __attribute__((address_space(3)))
typedef unsigned short bf16_t;
typedef short bf16x8 __attribute__((ext_vector_type(8)));
typedef short s16x4 __attribute__((ext_vector_type(4)));
typedef float f32x2 __attribute__((ext_vector_type(2)));
typedef float f32x4 __attribute__((ext_vector_type(4)));
typedef float f32x16 __attribute__((ext_vector_type(16)));
typedef unsigned u32x2 __attribute__((ext_vector_type(2)));
typedef unsigned u32x4 __attribute__((ext_vector_type(4)));

constexpr size_t WS_CTL = 0, CTL_ZERO_BYTES = 256 * 1024;
constexpr size_t WS_RW = 1 * MiB;
constexpr size_t WS_SSQ = 2 * MiB;
constexpr size_t WS_LIST = 4 * MiB;
constexpr size_t WS_WIN0 = 12 * MiB;
constexpr size_t WS_WOUT0 = 17 * MiB;
constexpr size_t WS_WCIN = 19 * MiB;
constexpr size_t WS_WCOUT = 25 * MiB;
constexpr size_t WS_WGU = 28 * MiB;
constexpr size_t WS_WD = 156 * MiB;
constexpr size_t WS_XN = 220 * MiB;
constexpr size_t WS_BIG = 284 * MiB;
constexpr size_t WS_H = WS_BIG, WS_Y0 = WS_BIG + 72 * MiB, WS_Y1 = WS_Y0 + 64 * MiB;
constexpr size_t WS_END = WS_BIG + 200 * MiB;
static_assert(WS_Y1 + 64 * MiB <= WS_END, "ws map");

constexpr int NWAVES = 8;
constexpr int NPHASE = 15;
constexpr int RING_OFF = 0, RING_BYTES = 131072;
constexpr int TAB_OFF = RING_BYTES, TAB_BYTES = 27648;
constexpr int MISC_OFF = TAB_OFF + TAB_BYTES;
constexpr int LDS_BYTES = MISC_OFF + 1024;
static_assert(LDS_BYTES <= 160 * 1024, "LDS");


constexpr int CW_TMO = 0;
constexpr int CW_CNT = 64;
constexpr int CW_LAM = 192;
constexpr int CW_BAR = 4096;

__device__ __forceinline__ float wave_sum(float v) {
#pragma unroll
    for (int o = 1; o < 64; o <<= 1) v += __shfl_xor(v, o);
    return v;
}
__device__ __forceinline__ float wave_max(float v) {
#pragma unroll
    for (int o = 1; o < 64; o <<= 1) v = fmaxf(v, __shfl_xor(v, o));
    return v;
}
__host__ __device__ __forceinline__ int t5_bucket(int rel) {
    int n = rel < 0 ? -rel : rel;
    int b = n < 8 ? n : (8 + (n >= 15) + (n >= 27) + (n >= 50) + (n >= 91) + (n >= 166) + (n >= 305) + (n >= 559));
    return (rel > 0 ? 16 : 0) + b;
}
__device__ __forceinline__ unsigned cvt_pk_bf16(float lo, float hi) { unsigned r; asm volatile("v_cvt_pk_bf16_f32 %0, %1, %2" : "=v"(r) : "v"(lo), "v"(hi)); return r; }
__device__ __forceinline__ float bf2f(bf16_t b) { return __uint_as_float((unsigned)b << 16); }
__device__ __forceinline__ float bflo(unsigned w) { return __uint_as_float(w << 16); }
__device__ __forceinline__ float bfhi(unsigned w) { return __uint_as_float(w & 0xffff0000u); }
#ifndef PROBE_T
#define PROBE_T 0
#endif
#define PT_BEGIN(id) unsigned long long pt_t0_##id = 0; if (PROBE_T == (id)) { asm volatile("s_waitcnt vmcnt(0) lgkmcnt(0)" ::: "memory"); pt_t0_##id = __builtin_amdgcn_s_memrealtime(); }
#define PT_END(id) if (PROBE_T == (id)) { asm volatile("s_waitcnt vmcnt(0) lgkmcnt(0)" ::: "memory"); if (threadIdx.x == 0) ((volatile LAS unsigned*)(lds + MISC_OFF))[240] += (unsigned)(__builtin_amdgcn_s_memrealtime() - pt_t0_##id); }
#define PT_BEGINX(id) if (PROBE_T == (id)) { asm volatile("s_waitcnt vmcnt(0) lgkmcnt(0)" ::: "memory"); ptx_ = __builtin_amdgcn_s_memrealtime(); }
#define PT_ENDX(id) if (PROBE_T == (id)) { asm volatile("s_waitcnt vmcnt(0) lgkmcnt(0)" ::: "memory"); if (threadIdx.x == 0) ((volatile LAS unsigned*)(lds + MISC_OFF))[240] += (unsigned)(__builtin_amdgcn_s_memrealtime() - ptx_); }
#define LDS_WAIT() asm volatile("s_waitcnt lgkmcnt(0)" ::: "memory")
#define VM_WAIT() asm volatile("s_waitcnt vmcnt(0)" ::: "memory")
namespace pg8 {
constexpr int BM = 256, BK = 64, HALF = 128, HTB = HALF * BK * 2, STAGE_BYTES = 8 * HTB, NXCD = 8, WGM = 8;
__host__ __device__ __forceinline__ int lds_byte(int r, int c) { const int st = (r >> 4) * 2 + (c >> 5), rr = r & 15, cc = c & 31, ob = rr * 64 + cc * 2; return st * 1024 + (ob ^ (((ob >> 9) & 1) << 5)); }
__host__ __device__ __forceinline__ void stage_rc(int b, int& R, int& C) { const int st = b / 1024, sb = b % 1024, swz = sb ^ (((sb >> 9) & 1) << 5); R = (st >> 1) * 16 + swz / 64; C = (st & 1) * 32 + (swz % 64) / 2; }
__host__ __device__ __forceinline__ int perm32(int rho) { const int n = rho >> 4, i = rho & 15; return 8 * (i >> 2) + 4 * n + (i & 3); }

struct Unit { int pm, pn, e, rows, lbase; unsigned aoff; size_t boff; };
struct Gemm { const bf16_t* A; const bf16_t* Bt; int lda, ldb, K; const int* list; };

struct DenseOrder {
    static constexpr bool GATHER = false;
    int nM, nN, nwg, G, c, rep; unsigned astep; size_t bstep;
    __device__ void init(int M, int N, int G_, int c_, int lda, int ldb, int rep_ = 1) { nM = M / BM; nN = N / BM; nwg = nM * nN; G = G_; c = c_; rep = rep_; astep = (unsigned)BM * lda * 2u; bstep = (size_t)BM * ldb * 2; }
    __device__ bool next(int i, Unit& u) const {
        long L = (long)i * G + c; if (L >= (long)nwg * rep) return false;
        if (L >= nwg) L -= nwg;
        int wgid = (int)L; { const int q = nwg / NXCD, r = nwg % NXCD, xcd = wgid % NXCD, off = wgid / NXCD; wgid = (xcd < r ? xcd * (q + 1) : r * (q + 1) + (xcd - r) * q) + off; }
        const int nig = WGM * nN, gid = wgid / nig, fm = gid * WGM, gsz = (nM - fm) < WGM ? (nM - fm) : WGM;
        u.pm = fm + ((wgid % nig) % gsz); u.pn = (wgid % nig) / gsz; u.e = 0; u.rows = BM; u.lbase = 0; u.aoff = (unsigned)u.pm * astep; u.boff = (size_t)u.pn * bstep; return true;
    }
};
template <bool GATH> struct MoeOrder {
    static constexpr bool GATHER = GATH;
    const LAS int* tb; const LAS int* cnt; int G, c, npn, NT; unsigned atile; size_t bexp, bpn; int rep;
    __device__ bool next(int i, Unit& u) const {
        int L = i * G + c; if (L >= NT * npn * rep) return false;
        if (L >= NT * npn) L -= NT * npn;
        const int T = L / npn; u.pn = L - T * npn; u.pm = T;
        int e = 0;
#pragma unroll 1
        for (int j = 1; j < NEXP; ++j) e = (tb[j] <= T) ? j : e;
        e = __builtin_amdgcn_readfirstlane(e);
        const int lt = T - tb[e]; const int r = cnt[e] - 256 * lt;
        u.e = e; u.rows = r < 256 ? r : 256; u.lbase = e * NTOK + 256 * lt; u.aoff = (unsigned)T * atile; u.boff = (size_t)e * bexp + (size_t)u.pn * bpn; return true;
    }
};

struct EpiBf16 {
    static constexpr int PID = 71;
    bf16_t* O; int ldc;
    __device__ __forceinline__ void operator()(const f32x4 (&acc)[2][2][4][2], const Unit& u, int wr, int wc, int fr, int fq) const {
        const int row0 = u.pm * BM + wr * 64 + fr, col0 = u.pn * BM + wc * 32 + 8 * fq;
#pragma unroll
        for (int ai = 0; ai < 2; ++ai)
#pragma unroll
            for (int m = 0; m < 4; ++m) { bf16_t* rowp = O + (size_t)(row0 + ai * HALF + m * 16) * ldc + col0;
#pragma unroll
                for (int bj = 0; bj < 2; ++bj) { const f32x4 v0 = acc[ai][bj][m][0], v1 = acc[ai][bj][m][1];
                    u32x4 w; w.x = cvt_pk_bf16(v0[0], v0[1]); w.y = cvt_pk_bf16(v0[2], v0[3]); w.z = cvt_pk_bf16(v1[0], v1[1]); w.w = cvt_pk_bf16(v1[2], v1[3]);
                    *(u32x4*)(rowp + bj * HALF) = w; } }
    }
};
template <bool ADDY> struct EpiResid {
    static constexpr int PID = 72;
    const float* R; float* out; const bf16_t* Y0; const bf16_t* Y1; float* ssq;
    __device__ __forceinline__ void operator()(const f32x4 (&acc)[2][2][4][2], const Unit& u, int wr, int wc, int fr, int fq) const {
        const int row0 = u.pm * BM + wr * 64 + fr, col0 = u.pn * BM + wc * 32 + 8 * fq;
#pragma unroll
        for (int ai = 0; ai < 2; ++ai) {
            f32x4 rv[4][2][2];
#pragma unroll
            for (int m = 0; m < 4; ++m) { const size_t off = (size_t)(row0 + ai * HALF + m * 16) * D + col0;
#pragma unroll
                for (int bj = 0; bj < 2; ++bj) { rv[m][bj][0] = *(const f32x4*)(R + off + bj * HALF); rv[m][bj][1] = *(const f32x4*)(R + off + bj * HALF + 4); } }
#pragma unroll
            for (int m = 0; m < 4; ++m) { const int row = row0 + ai * HALF + m * 16; const size_t off = (size_t)row * D + col0; float ss = 0.f;
#pragma unroll
                for (int bj = 0; bj < 2; ++bj) {
                    f32x4 v0 = acc[ai][bj][m][0] + rv[m][bj][0], v1 = acc[ai][bj][m][1] + rv[m][bj][1];
                    if (ADDY) { const u32x4 a = *(const u32x4*)(Y0 + off + bj * HALF), b = *(const u32x4*)(Y1 + off + bj * HALF);
                        v0[0] += bflo(a.x) + bflo(b.x); v0[1] += bfhi(a.x) + bfhi(b.x); v0[2] += bflo(a.y) + bflo(b.y); v0[3] += bfhi(a.y) + bfhi(b.y);
                        v1[0] += bflo(a.z) + bflo(b.z); v1[1] += bfhi(a.z) + bfhi(b.z); v1[2] += bflo(a.w) + bflo(b.w); v1[3] += bfhi(a.w) + bfhi(b.w); }
                    *(f32x4*)(out + off + bj * HALF) = v0; *(f32x4*)(out + off + bj * HALF + 4) = v1;
                    ss += v0[0] * v0[0] + v0[1] * v0[1] + v0[2] * v0[2] + v0[3] * v0[3] + v1[0] * v1[0] + v1[1] * v1[1] + v1[2] * v1[2] + v1[3] * v1[3]; }
                ss += __shfl_xor(ss, 16); ss += __shfl_xor(ss, 32);
                if (fq == 0) ssq[(size_t)row * 16 + u.pn * 4 + wc] = ss; }
        }
    }
};
struct EpiSwiglu {
    static constexpr int PID = 73;
    bf16_t* H;
    __device__ __forceinline__ void operator()(const f32x4 (&acc)[2][2][4][2], const Unit& u, int wr, int wc, int fr, int fq) const {
        const int row0 = u.pm * BM + wr * 64 + fr, col0 = u.pn * HALF + wc * 32 + 8 * fq;
#pragma unroll
        for (int ai = 0; ai < 2; ++ai)
#pragma unroll
            for (int m = 0; m < 4; ++m) { float o[8];
#pragma unroll
                for (int n = 0; n < 2; ++n)
#pragma unroll
                    for (int j = 0; j < 4; ++j) { const float g = acc[ai][0][m][n][j], up = acc[ai][1][m][n][j];
                        o[n * 4 + j] = g * __builtin_amdgcn_rcpf(1.f + __builtin_amdgcn_exp2f(-g * LOG2E)) * up; }
                u32x4 w; w.x = cvt_pk_bf16(o[0], o[1]); w.y = cvt_pk_bf16(o[2], o[3]); w.z = cvt_pk_bf16(o[4], o[5]); w.w = cvt_pk_bf16(o[6], o[7]);
                *(u32x4*)(H + (size_t)(row0 + ai * HALF + m * 16) * DEXP + col0) = w; }
    }
};
struct EpiScatter {
    static constexpr int PID = 74;
    bf16_t* Y0; bf16_t* Y1; const int* list; const float* lw;
    __device__ __forceinline__ void operator()(const f32x4 (&acc)[2][2][4][2], const Unit& u, int wr, int wc, int fr, int fq) const {
        const int col0 = u.pn * BM + wc * 32 + 8 * fq;
        int ent[8]; float wgt[8];
#pragma unroll
        for (int k = 0; k < 8; ++k) { const int r = (k >> 2) * HALF + wr * 64 + (k & 3) * 16 + fr; const bool ok = r < u.rows; ent[k] = ok ? list[u.lbase + r] : -1; wgt[k] = ok ? lw[u.lbase + r] : 0.f; }
        const size_t ystride = (size_t)(Y1 - Y0);
#pragma unroll
        for (int ai = 0; ai < 2; ++ai)
#pragma unroll
            for (int m = 0; m < 4; ++m) { const int e = ent[ai * 4 + m]; const float w = wgt[ai * 4 + m];
                if (e >= 0) { bf16_t* rowp = Y0 + (size_t)(e & 1) * ystride + (size_t)(e >> 1) * D + col0;
#pragma unroll
                    for (int bj = 0; bj < 2; ++bj) { const f32x4 v0 = acc[ai][bj][m][0] * w, v1 = acc[ai][bj][m][1] * w;
                        u32x4 o; o.x = cvt_pk_bf16(v0[0], v0[1]); o.y = cvt_pk_bf16(v0[2], v0[3]); o.z = cvt_pk_bf16(v1[0], v1[1]); o.w = cvt_pk_bf16(v1[2], v1[3]);
                        *(u32x4*)(rowp + bj * HALF) = o; } } }
    }
};

template <class Epi, class Sched, bool ALIGN_EPI = true>
__device__ __forceinline__ void gemm_phase(LAS unsigned char* lds, const Gemm g, const Sched& S, const Epi& E) {
    const int tid = threadIdx.x, wid = __builtin_amdgcn_readfirstlane(tid >> 6), lane = tid & 63, wr = wid >> 2, wc = wid & 3, fr = lane & 15, fq = lane >> 4;
    const int K = g.K, nt = K / BK;
    int R0, C0; stage_rc(tid * 16, R0, C0);
    unsigned voffB[2];
#pragma unroll
    for (int i = 0; i < 2; ++i) { const int R = R0 + 64 * i; const int Rb = (R & ~31) + perm32(R & 31); voffB[i] = (unsigned)(Rb * g.ldb + C0) * 2u; }
    const unsigned rowb = (unsigned)g.lda * 2u, colb = (unsigned)C0 * 2u;
    const unsigned kstep = (unsigned)(BK * 2);
    const size_t hstepB = (size_t)HALF * g.ldb * 2;
    const unsigned ldsw = (unsigned)wid * 1024u;
    const int aoff = lds_byte(wr * 64 + fr, fq * 8), boff = lds_byte(wc * 32 + fr, fq * 8);
    const char* Ab = (const char*)g.A;
#define PG8_SA(b, h) (((b) * 2 + (h)) * HTB)
#define PG8_SB(b, h) ((4 + (b) * 2 + (h)) * HTB)
#define PG8_STAGEB(bufoff, gbase) do { _Pragma("unroll") for (int _i = 0; _i < 2; ++_i) \
        __builtin_amdgcn_global_load_lds((const unsigned*)((const char*)(gbase) + voffB[_i]), (LAS unsigned*)(lds + (bufoff) + ldsw + _i * 8192), 16, 0, 0); } while (0)
#define PG8_STAGEA(bufoff, arr, h, kb) do { _Pragma("unroll") for (int _i = 0; _i < 2; ++_i) \
        __builtin_amdgcn_global_load_lds((const unsigned*)(Ab + (size_t)((arr)[2 * (h) + _i] + (kb))), (LAS unsigned*)(lds + (bufoff) + ldsw + _i * 8192), 16, 0, 0); } while (0)
#define PG8_LDA(dst, b, h) do { _Pragma("unroll") for (int m = 0; m < 4; ++m) _Pragma("unroll") for (int k = 0; k < 2; ++k) dst[m][k] = *(const LAS bf16x8*)(lds + PG8_SA(b, h) + aoff + m * 2048 + k * 1024); } while (0)
#define PG8_LDB(dst, b, h) do { _Pragma("unroll") for (int n = 0; n < 2; ++n) _Pragma("unroll") for (int k = 0; k < 2; ++k) dst[n][k] = *(const LAS bf16x8*)(lds + PG8_SB(b, h) + boff + n * 2048 + k * 1024); } while (0)
#define PG8_MMA(ai, bj, At, Bt) do { __builtin_amdgcn_s_setprio(1); _Pragma("unroll") for (int m = 0; m < 4; ++m) _Pragma("unroll") for (int n = 0; n < 2; ++n) _Pragma("unroll") for (int k = 0; k < 2; ++k) \
        acc[ai][bj][m][n] = __builtin_amdgcn_mfma_f32_16x16x32_bf16(Bt[n][k], At[m][k], acc[ai][bj][m][n], 0, 0, 0); __builtin_amdgcn_s_setprio(0); } while (0)
#define PG8_WAIT_V(n) asm volatile("s_waitcnt vmcnt(" #n ")" ::: "memory")
#define PG8_WAIT_L(n) asm volatile("s_waitcnt lgkmcnt(" #n ")" ::: "memory")
#define PG8_BAR __builtin_amdgcn_s_barrier()
#define PG8_SCHED __builtin_amdgcn_sched_barrier(0)
#define PG8_ROWS(arr, u) do { _Pragma("unroll") for (int _j = 0; _j < 4; ++_j) { \
        if constexpr (Sched::GATHER) { const int _r = R0 + 64 * _j; const int _ent = (_r < (u).rows) ? g.list[(u).lbase + _r] : 0; (arr)[_j] = (unsigned)(_ent >> 1) * rowb + colb; } \
        else (arr)[_j] = (u).aoff + (unsigned)(R0 + 64 * _j) * rowb + colb; } } while (0)
    Unit cur, nxt; int ui = 0;
    if (!S.next(0, cur)) return;
    f32x4 acc[2][2][4][2];
#pragma unroll
    for (int a = 0; a < 2; ++a)
#pragma unroll
        for (int b = 0; b < 2; ++b)
#pragma unroll
            for (int m = 0; m < 4; ++m)
#pragma unroll
                for (int n = 0; n < 2; ++n) acc[a][b][m][n] = (f32x4){0.f, 0.f, 0.f, 0.f};
    bf16x8 At[4][2], B0[2][2], B1[2][2];
    unsigned ca[4], na[4];
    PG8_ROWS(ca, cur);
    const char* cB = (const char*)g.Bt + cur.boff;
    PG8_STAGEB(PG8_SB(0, 0), cB); PG8_STAGEB(PG8_SB(0, 1), cB + hstepB); PG8_STAGEA(PG8_SA(0, 0), ca, 0, 0u); PG8_STAGEA(PG8_SA(0, 1), ca, 1, 0u);
    if (wr == 1) PG8_BAR;
    PG8_WAIT_V(2); PG8_BAR;
    PG8_STAGEB(PG8_SB(1, 0), cB + kstep); PG8_STAGEA(PG8_SA(1, 0), ca, 0, kstep); PG8_STAGEB(PG8_SB(1, 1), cB + hstepB + kstep);
    PG8_WAIT_V(6); PG8_BAR;
    for (;;) {
        const bool has_next = S.next(ui + 1, nxt);
        if (has_next) { PG8_ROWS(na, nxt); } else {
#pragma unroll
            for (int j = 0; j < 4; ++j) na[j] = ca[j]; }
        const char* nB = has_next ? (const char*)g.Bt + nxt.boff : cB;
        for (int t = 0; t < nt; t += 2) {
            const bool last = (t == nt - 2);
            const unsigned k1 = (unsigned)(t + 1) * kstep;
            const unsigned k2 = last ? 0u : (unsigned)(t + 2) * kstep, k3 = k2 + kstep;
            unsigned a2[4];
#pragma unroll
            for (int j = 0; j < 4; ++j) a2[j] = last ? na[j] : ca[j];
            const char* b2 = (last ? nB : cB) + k2; const char* b3 = b2 + kstep;
            PG8_LDB(B0, 0, 0); PG8_LDB(B1, 0, 1); PG8_SCHED; PG8_LDA(At, 0, 0); PG8_STAGEA(PG8_SA(1, 1), ca, 1, k1);
            PG8_WAIT_V(8); PG8_WAIT_L(0); PG8_BAR; PG8_MMA(0, 0, At, B0); PG8_MMA(0, 1, At, B1); PG8_BAR; PG8_SCHED;
            PG8_LDA(At, 0, 1); PG8_STAGEB(PG8_SB(0, 0), b2); PG8_STAGEB(PG8_SB(0, 1), b2 + hstepB); PG8_STAGEA(PG8_SA(0, 0), a2, 0, k2);
            PG8_WAIT_V(8); PG8_WAIT_L(0); PG8_BAR; PG8_MMA(1, 0, At, B0); PG8_MMA(1, 1, At, B1); PG8_BAR; PG8_SCHED;
            PG8_LDB(B0, 1, 0); PG8_LDB(B1, 1, 1); PG8_SCHED; PG8_LDA(At, 1, 0); PG8_STAGEA(PG8_SA(0, 1), a2, 1, k2);
            PG8_WAIT_V(8); PG8_WAIT_L(0); PG8_BAR; PG8_MMA(0, 0, At, B0); PG8_MMA(0, 1, At, B1); PG8_BAR; PG8_SCHED;
            PG8_LDA(At, 1, 1); PG8_STAGEB(PG8_SB(1, 0), b3); PG8_STAGEB(PG8_SB(1, 1), b3 + hstepB); PG8_STAGEA(PG8_SA(1, 0), a2, 0, k3);
            PG8_WAIT_V(8); PG8_WAIT_L(0); PG8_BAR; PG8_MMA(1, 0, At, B0); PG8_MMA(1, 1, At, B1); PG8_BAR; PG8_SCHED;
        }
        if constexpr (ALIGN_EPI) { if (wr == 0) PG8_BAR; }
        { unsigned long long pte_ = 0; if (PROBE_T == 70 || PROBE_T == Epi::PID) { asm volatile("s_waitcnt vmcnt(0) lgkmcnt(0)" ::: "memory"); pte_ = __builtin_amdgcn_s_memrealtime(); }
          E(acc, cur, wr, wc, fr, fq);
          if (PROBE_T == 70 || PROBE_T == Epi::PID) { asm volatile("s_waitcnt vmcnt(0) lgkmcnt(0)" ::: "memory"); if (threadIdx.x == 0) ((volatile LAS unsigned*)(lds + MISC_OFF))[240] += (unsigned)(__builtin_amdgcn_s_memrealtime() - pte_); } }
        if (!has_next) break;
#pragma unroll
        for (int a = 0; a < 2; ++a)
#pragma unroll
            for (int b = 0; b < 2; ++b)
#pragma unroll
                for (int m = 0; m < 4; ++m)
#pragma unroll
                    for (int n = 0; n < 2; ++n) acc[a][b][m][n] = (f32x4){0.f, 0.f, 0.f, 0.f};
        cur = nxt; cB = nB; ++ui;
#pragma unroll
        for (int j = 0; j < 4; ++j) ca[j] = na[j];
        if constexpr (ALIGN_EPI) { if (wr == 1) PG8_BAR; }
    }
    PG8_WAIT_V(0);
    if constexpr (!ALIGN_EPI) { if (wr == 0) PG8_BAR; }
    PG8_BAR;
#undef PG8_SA
#undef PG8_SB
#undef PG8_STAGEA
#undef PG8_STAGEB
#undef PG8_LDA
#undef PG8_LDB
#undef PG8_MMA
#undef PG8_WAIT_V
#undef PG8_WAIT_L
#undef PG8_BAR
#undef PG8_SCHED
#undef PG8_ROWS
}
}
#define XB_TMO      128
#define XB_XCNT(j)  (256  + 64 * (j))
#define XB_XSUB(j)  (1280 + 64 * (j))
#define XB_XGEN(j)  (2304 + 64 * (j))
#define XB_TOP      3328
#define XB_TOPGEN   3392
#define XCD_BAR_WORDS 3456
#define XB_SPIN_CAP (1u << 18)

__device__ __forceinline__ unsigned xb_ld(unsigned* p)              { return __hip_atomic_load(p, __ATOMIC_RELAXED, __HIP_MEMORY_SCOPE_AGENT); }
__device__ __forceinline__ unsigned xb_add(unsigned* p, unsigned v) { return __hip_atomic_fetch_add(p, v, __ATOMIC_RELAXED, __HIP_MEMORY_SCOPE_AGENT); }
__device__ __forceinline__ unsigned xb_xcc_id() { return (unsigned)__builtin_amdgcn_s_getreg((3 << 11) | 20) & 0xFu; }
#define XB_SPIN(cond, bar) do { unsigned _sp = 0; while (cond) { __builtin_amdgcn_s_sleep(1); \
    if ((++_sp & 255u) == 0u) { if (xb_ld(&(bar)[XB_TMO])) break; if (_sp > XB_SPIN_CAP) { atomicAdd(&(bar)[XB_TMO], 1u); break; } } } } while (0)

struct XcdBarrier {
    unsigned* bar; unsigned x;
    volatile LAS unsigned* st;
};

__device__ __forceinline__ XcdBarrier xcd_barrier_post(unsigned* bar, volatile LAS unsigned* st) {
    XcdBarrier b; b.bar = bar; b.x = xb_xcc_id(); b.st = st;
    if (threadIdx.x == 0) (void)xb_add(&bar[XB_XCNT(b.x)], 1u);
    return b;
}
__device__ __forceinline__ void xcd_barrier_complete(unsigned* bar, unsigned x, unsigned& nloc, unsigned& nx) {
    const unsigned G = gridDim.x * gridDim.y * gridDim.z;
    unsigned sum, cnt, mine, sp = 0u;
    for (;;) {
        sum = 0u; cnt = 0u; mine = 0u;
#pragma unroll
        for (unsigned j = 0; j < 16; ++j) { const unsigned c = xb_ld(&bar[XB_XCNT(j)]); sum += c; cnt += (c > 0u) ? 1u : 0u; mine = (j == x) ? c : mine; }
        if (sum == G) break;
        __builtin_amdgcn_s_sleep(1);
        if ((++sp & 255u) == 0u) { if (xb_ld(&bar[XB_TMO])) break; if (sp > XB_SPIN_CAP) { atomicAdd(&bar[XB_TMO], 1u); break; } }
    }
    nloc = mine > 0u ? mine : 1u; nx = cnt > 0u ? cnt : 1u;
}

__device__ __forceinline__ void xcd_barrier(const XcdBarrier& b) {
    asm volatile("s_waitcnt vmcnt(0)" ::: "memory");
    __syncthreads();
    if (threadIdx.x == 0) {
        unsigned* bar = b.bar;
        __builtin_amdgcn_s_waitcnt(0);
        unsigned nloc = b.st[0], nx = b.st[1];
        if (nloc == 0u) { xcd_barrier_complete(bar, b.x, nloc, nx); b.st[0] = nloc; b.st[1] = nx; }
        const unsigned old = xb_add(&bar[XB_XSUB(b.x)], 1u);
        const unsigned gen = old / nloc;
        if (old + 1u == (gen + 1u) * nloc) {
            __builtin_amdgcn_fence(__ATOMIC_RELEASE, "agent");
            asm volatile("s_waitcnt vmcnt(0)" ::: "memory");
            const unsigned og = xb_add(&bar[XB_TOP], 1u);
            const unsigned tg = og / nx;
            if (og + 1u == (tg + 1u) * nx) xb_add(&bar[XB_TOPGEN], 1u);
            else XB_SPIN(xb_ld(&bar[XB_TOPGEN]) == tg, bar);
            __builtin_amdgcn_fence(__ATOMIC_ACQUIRE, "agent");
            xb_add(&bar[XB_XGEN(b.x)], 1u);
            asm volatile("s_waitcnt vmcnt(0)" ::: "memory");
        } else {
            XB_SPIN(xb_ld(&bar[XB_XGEN(b.x)]) == gen, bar);
            __builtin_amdgcn_fence(__ATOMIC_ACQUIRE, "agent");
            asm volatile("s_waitcnt vmcnt(0)" ::: "memory");
        }
    }
    __syncthreads();
}
__device__ __forceinline__ unsigned f2bf(float f) { unsigned u = __builtin_bit_cast(unsigned, f); return (u + 0x7fffu + ((u >> 16) & 1u)) >> 16; }
__device__ __forceinline__ unsigned pk2(float lo, float hi) { return f2bf(lo) | (f2bf(hi) << 16); }

__device__ __forceinline__ void conv_item(const float* W, int K, int N, bf16_t* WT, int k0, int n0, int dst_row0, float scale, LAS float* scr, int lane) {
    const int nn = n0 + (lane & 31); const bool ok = nn < N;
    float wv[32];
#pragma unroll
    for (int i = 0; i < 32; ++i) { const int kk = 2 * i + (lane >> 5); wv[i] = ok ? W[(size_t)(k0 + kk) * N + nn] : 0.f; }
#pragma unroll
    for (int i = 0; i < 32; ++i) { const int kk = 2 * i + (lane >> 5); scr[kk * 33 + (lane & 31)] = wv[i] * scale; }
    LDS_WAIT(); asm volatile("" ::: "memory");
    const int c = lane & 7;
#pragma unroll
    for (int j = 0; j < 4; ++j) { const int n = (lane >> 3) + 8 * j; const LAS float* s = scr + (8 * c) * 33 + n;
        u32x4 o; o.x = pk2(s[0 * 33], s[1 * 33]); o.y = pk2(s[2 * 33], s[3 * 33]); o.z = pk2(s[4 * 33], s[5 * 33]); o.w = pk2(s[6 * 33], s[7 * 33]);
        *(GAS u32x4*)(WT + (size_t)(dst_row0 + n) * K + k0 + 8 * c) = o; }
    LDS_WAIT(); asm volatile("" ::: "memory");
}

struct RowIO { const float* src; const bf16_t* y0; const bf16_t* y1; const float* gain; bf16_t* xn; float* fout; };
template <bool ADDY, bool WXN, bool WSUM, bool WNORM>
__device__ __forceinline__ void rms_row(const RowIO& io, int row, int lane) {
    const GAS f32x4* xr = (const GAS f32x4*)(io.src + (size_t)row * D) + lane;
    f32x4 v[4]; float s = 0.f;
#pragma unroll
    for (int j = 0; j < 4; ++j) v[j] = xr[64 * j];
    if (ADDY) {
        const GAS u32x2* a = (const GAS u32x2*)(io.y0 + (size_t)row * D) + lane; const GAS u32x2* b = (const GAS u32x2*)(io.y1 + (size_t)row * D) + lane;
#pragma unroll
        for (int j = 0; j < 4; ++j) { const u32x2 ya = a[64 * j], yb = b[64 * j];
            v[j][0] += bflo(ya.x) + bflo(yb.x); v[j][1] += bfhi(ya.x) + bfhi(yb.x); v[j][2] += bflo(ya.y) + bflo(yb.y); v[j][3] += bfhi(ya.y) + bfhi(yb.y); }
    }
#pragma unroll
    for (int j = 0; j < 4; ++j) s += (v[j][0] * v[j][0] + v[j][1] * v[j][1]) + (v[j][2] * v[j][2] + v[j][3] * v[j][3]);
    const float r = __builtin_amdgcn_rsqf(wave_sum(s) * (1.f / D) + EPS);
    const GAS f32x4* gg = (const GAS f32x4*)io.gain + lane;
#pragma unroll
    for (int j = 0; j < 4; ++j) { const f32x4 o = v[j] * r * gg[64 * j];
        if (WSUM) ((GAS f32x4*)(io.fout + (size_t)row * D) + lane)[64 * j] = v[j];
        if (WXN) { u32x2 w; w.x = cvt_pk_bf16(o[0], o[1]); w.y = cvt_pk_bf16(o[2], o[3]); ((GAS u32x2*)(io.xn + (size_t)row * D) + lane)[64 * j] = w; }
        if (WNORM) ((GAS f32x4*)(io.fout + (size_t)row * D) + lane)[64 * j] = o; }
}

template <bool ADDY, bool WXN, bool WSUM, bool WNORM>
__device__ __forceinline__ void rms_row2(const RowIO& io, int row0, int row1, int lane) {
    f32x4 v[2][4]; u32x2 ya[2][4], yb[2][4];
#pragma unroll
    for (int k = 0; k < 2; ++k) { const int row = k ? row1 : row0; const GAS f32x4* xr = (const GAS f32x4*)(io.src + (size_t)row * D) + lane;
#pragma unroll
        for (int j = 0; j < 4; ++j) v[k][j] = xr[64 * j];
        if (ADDY) { const GAS u32x2* a = (const GAS u32x2*)(io.y0 + (size_t)row * D) + lane; const GAS u32x2* b = (const GAS u32x2*)(io.y1 + (size_t)row * D) + lane;
#pragma unroll
            for (int j = 0; j < 4; ++j) { ya[k][j] = a[64 * j]; yb[k][j] = b[64 * j]; } } }
    f32x4 gg[4];
    { const GAS f32x4* gp = (const GAS f32x4*)io.gain + lane;
#pragma unroll
      for (int j = 0; j < 4; ++j) gg[j] = gp[64 * j]; }
#pragma unroll
    for (int k = 0; k < 2; ++k) { const int row = k ? row1 : row0; float s = 0.f;
        if (ADDY) {
#pragma unroll
            for (int j = 0; j < 4; ++j) { v[k][j][0] += bflo(ya[k][j].x) + bflo(yb[k][j].x); v[k][j][1] += bfhi(ya[k][j].x) + bfhi(yb[k][j].x); v[k][j][2] += bflo(ya[k][j].y) + bflo(yb[k][j].y); v[k][j][3] += bfhi(ya[k][j].y) + bfhi(yb[k][j].y); } }
#pragma unroll
        for (int j = 0; j < 4; ++j) s += (v[k][j][0] * v[k][j][0] + v[k][j][1] * v[k][j][1]) + (v[k][j][2] * v[k][j][2] + v[k][j][3] * v[k][j][3]);
        const float r = __builtin_amdgcn_rsqf(wave_sum(s) * (1.f / D) + EPS);
#pragma unroll
        for (int j = 0; j < 4; ++j) { const f32x4 o = v[k][j] * r * gg[j];
            if (WSUM) ((GAS f32x4*)(io.fout + (size_t)row * D) + lane)[64 * j] = v[k][j];
            if (WXN) { u32x2 w; w.x = cvt_pk_bf16(o[0], o[1]); w.y = cvt_pk_bf16(o[2], o[3]); ((GAS u32x2*)(io.xn + (size_t)row * D) + lane)[64 * j] = w; }
            if (WNORM) ((GAS f32x4*)(io.fout + (size_t)row * D) + lane)[64 * j] = o; } }
}
__device__ __forceinline__ void router_phase(LAS unsigned char* lds, volatile LAS unsigned* MISC, const float* hbuf, const float* SSQ, const float* gain, const bf16_t* RWl, const float* brg, const float* bre,
                                             bf16_t* XN, unsigned* gcnt, int* LIST, float* LW, int vcu, int G, int wave, int lane, int tid) {
    constexpr int WLO_OFF = 73728, GAIN_OFF = 147456;
    LAS float* lg = (LAS float*)(lds + RING_OFF) + wave * (16 * 48);
    volatile LAS unsigned* lcnt = MISC + 64;
    volatile LAS unsigned* lbase = MISC + 96;
    const int tr = lane & 15, g = lane >> 4;
    constexpr int NTILE = NTOK / 16;
    const int rounds = (NTILE + G * NWAVES - 1) / (G * NWAVES);
    LAS float* glds = (LAS float*)(lds + GAIN_OFF);
    __syncthreads(); if (tid < 2 * NEXP) MISC[64 + tid] = 0u; for (int i = tid; i < D / 4; i += NWAVES * 64) ((LAS f32x4*)glds)[i] = ((const GAS f32x4*)gain)[i]; __syncthreads();
    for (int r = 0; r < rounds; ++r) {
        for (int pid = tid; pid < 9216; pid += NWAVES * 64) { const int hl = pid / 4608, rem = pid % 4608, e = rem >> 7, p = rem & 127;
            *(LAS u32x4*)(lds + hl * WLO_OFF + e * 2048 + ((p ^ (e & 15)) << 4)) = *(const GAS u32x4*)(RWl + ((size_t)(hl * 48 + e) * D + p * 8)); }
        __syncthreads();
        const int tile = (r * G + vcu) * NWAVES + wave;
        const bool act = tile < NTILE;
        int e1 = 0, e2 = 0, p1 = 0, p2 = 0; float w1 = 0.f, w2 = 0.f; int tok = 0;
        f32x4 acc[3] = {(f32x4){0.f, 0.f, 0.f, 0.f}, (f32x4){0.f, 0.f, 0.f, 0.f}, (f32x4){0.f, 0.f, 0.f, 0.f}};
        if (act) {
            const int t0 = tile * 16; tok = t0 + tr;
            const GAS f32x4* sq = (const GAS f32x4*)(SSQ + (size_t)tok * 16);
            const f32x4 s0 = sq[0], s1 = sq[1], s2 = sq[2], s3 = sq[3];
            const float ss = ((s0[0] + s0[1]) + (s0[2] + s0[3])) + ((s1[0] + s1[1]) + (s1[2] + s1[3])) + ((s2[0] + s2[1]) + (s2[2] + s2[3])) + ((s3[0] + s3[1]) + (s3[2] + s3[3]));
            const float rstd = __builtin_amdgcn_rsqf(ss * (1.f / D) + EPS);
            const float* hrow = hbuf + (size_t)tok * D + 8 * g;
            const LAS float* gl = glds + 8 * g;
            bf16_t* xrow = XN + (size_t)tok * D + 8 * g;
            PT_BEGIN(40)
#pragma unroll 1
            for (int hf = 0; hf < 2; ++hf) {
                f32x4 hh[16][2];
#pragma unroll
                for (int k2 = 0; k2 < 16; ++k2) { hh[k2][0] = *(const GAS f32x4*)(hrow + 32 * (16 * hf + k2)); hh[k2][1] = *(const GAS f32x4*)(hrow + 32 * (16 * hf + k2) + 4); }
#pragma unroll
                for (int k2 = 0; k2 < 16; ++k2) { const int ks = 16 * hf + k2;
                    const f32x4 g0 = *(const LAS f32x4*)(gl + 32 * ks), g1 = *(const LAS f32x4*)(gl + 32 * ks + 4);
                    const f32x4 x0 = hh[k2][0] * rstd * g0, x1 = hh[k2][1] * rstd * g1;
                    u32x4 hi; hi.x = cvt_pk_bf16(x0[0], x0[1]); hi.y = cvt_pk_bf16(x0[2], x0[3]); hi.z = cvt_pk_bf16(x1[0], x1[1]); hi.w = cvt_pk_bf16(x1[2], x1[3]);
                    *(GAS u32x4*)(xrow + 32 * ks) = hi;
                    u32x4 lo; lo.x = cvt_pk_bf16(x0[0] - bflo(hi.x), x0[1] - bfhi(hi.x)); lo.y = cvt_pk_bf16(x0[2] - bflo(hi.y), x0[3] - bfhi(hi.y));
                    lo.z = cvt_pk_bf16(x1[0] - bflo(hi.z), x1[1] - bfhi(hi.z)); lo.w = cvt_pk_bf16(x1[2] - bflo(hi.w), x1[3] - bfhi(hi.w));
                    const bf16x8 ahi = __builtin_bit_cast(bf16x8, hi), alo = __builtin_bit_cast(bf16x8, lo);
#pragma unroll
                    for (int nt = 0; nt < 3; ++nt) {
                        const int er = (16 * nt + tr) < 36 ? (16 * nt + tr) : 35;
                        const LAS unsigned char* wp = lds + er * 2048 + (((4 * ks + g) ^ (er & 15)) << 4);
                        const bf16x8 bh = *(const LAS bf16x8*)wp, bl = *(const LAS bf16x8*)(wp + WLO_OFF);
                        acc[nt] = __builtin_amdgcn_mfma_f32_16x16x32_bf16(ahi, bh, acc[nt], 0, 0, 0);
                        acc[nt] = __builtin_amdgcn_mfma_f32_16x16x32_bf16(ahi, bl, acc[nt], 0, 0, 0);
                        acc[nt] = __builtin_amdgcn_mfma_f32_16x16x32_bf16(alo, bh, acc[nt], 0, 0, 0);
                    }
                }
            }
            PT_END(40)
        }
        __syncthreads();
        if (act) {
#pragma unroll
            for (int nt = 0; nt < 3; ++nt)
#pragma unroll
                for (int i = 0; i < 4; ++i) lg[(4 * g + i) * 48 + 16 * nt + tr] = acc[nt][i];
            LDS_WAIT();
            if (lane < 16) {
                const LAS float* l = lg + lane * 48;
                float gl[4];
#pragma unroll
                for (int i = 0; i < 4; ++i) gl[i] = l[i] + brg[i];
                int gs = 0; float gm = gl[0];
#pragma unroll
                for (int i = 1; i < 4; ++i) if (gl[i] > gm) { gm = gl[i]; gs = i; }
                float gsum = 0.f;
#pragma unroll
                for (int i = 0; i < 4; ++i) gsum += __expf(gl[i] - gm);
                const float pg = 1.f / gsum;
                float el[8];
#pragma unroll
                for (int i = 0; i < 8; ++i) el[i] = l[4 + gs * 8 + i] + bre[gs * 8 + i];
                float em = el[0];
#pragma unroll
                for (int i = 1; i < 8; ++i) em = fmaxf(em, el[i]);
                float pe[8], esum = 0.f;
#pragma unroll
                for (int i = 0; i < 8; ++i) { pe[i] = __expf(el[i] - em); esum += pe[i]; }
#pragma unroll
                for (int i = 0; i < 8; ++i) pe[i] /= esum;
                int i1 = 0; float v1 = pe[0];
#pragma unroll
                for (int i = 1; i < 8; ++i) if (pe[i] > v1) { v1 = pe[i]; i1 = i; }
                int i2 = -1; float v2 = -1.f;
#pragma unroll
                for (int i = 0; i < 8; ++i) if (i != i1 && pe[i] > v2) { v2 = pe[i]; i2 = i; }
                const float tw = v1 + v2;
                w1 = v1 / tw * pg; w2 = v2 / tw * pg; e1 = gs * 8 + i1; e2 = gs * 8 + i2;
                p1 = (int)__hip_atomic_fetch_add((LAS unsigned*)&lcnt[e1], 1u, __ATOMIC_RELAXED, __HIP_MEMORY_SCOPE_WORKGROUP);
                p2 = (int)__hip_atomic_fetch_add((LAS unsigned*)&lcnt[e2], 1u, __ATOMIC_RELAXED, __HIP_MEMORY_SCOPE_WORKGROUP);
            }
        }
        __syncthreads();
        if (tid < NEXP) { const unsigned c = lcnt[tid]; lbase[tid] = c ? __hip_atomic_fetch_add(gcnt + tid, c, __ATOMIC_RELAXED, __HIP_MEMORY_SCOPE_AGENT) : 0u; lcnt[tid] = 0u; }
        __syncthreads();
        if (act && lane < 16) {
            const int s1 = e1 * NTOK + (int)lbase[e1] + p1, s2 = e2 * NTOK + (int)lbase[e2] + p2;
            LIST[s1] = tok * 2; LW[s1] = w1; LIST[s2] = tok * 2 + 1; LW[s2] = w2;
        }
        __syncthreads();
    }
}
namespace at {
typedef const LAS char* lds_cptr;
typedef short v4i16_t __attribute__((ext_vector_type(4)));
__device__ __forceinline__ int crow(int r, int hi) { return (r & 3) + 8 * (r >> 2) + 4 * hi; }
__device__ __forceinline__ void glds16(const void* gsrc, unsigned lds_dst) { unsigned keep;
    asm volatile("s_mov_b32 %0, m0\n\ts_mov_b32 m0, %2\n\ts_nop 0\n\tglobal_load_lds_dwordx4 %1, off\n\ts_mov_b32 m0, %0" : "=&s"(keep) : "v"(gsrc), "s"(lds_dst) : "memory"); }
#define AT_WAIT_BAR() asm volatile("s_waitcnt vmcnt(0) lgkmcnt(0)\n\ts_barrier" ::: "memory")
#define AT_BAR() asm volatile("s_waitcnt lgkmcnt(0)\n\ts_barrier" ::: "memory")
__device__ __forceinline__ unsigned cvtpk(float lo, float hi) { typedef float f2 __attribute__((ext_vector_type(2))); typedef __bf16 b2 __attribute__((ext_vector_type(2))); f2 v = {lo, hi}; b2 b = __builtin_convertvector(v, b2); return __builtin_bit_cast(unsigned, b); }
__device__ __forceinline__ s16x4 vtr(lds_cptr p) { return __builtin_bit_cast(s16x4, __builtin_amdgcn_ds_read_tr16_b64_v4i16((LAS v4i16_t*)p)); }

__device__ __forceinline__ int kpiece(int r32, int hi, int d0) { return ((2 * d0 + hi) ^ (r32 & 7)) * 16; }
__device__ __forceinline__ int ksrc_piece(int lane) { return ((lane & 7) ^ (lane >> 3)) * 8; }
__device__ __forceinline__ void qkt(f32x16& p0, f32x16& p1, lds_cptr Kslot, const bf16x8* qr, int r32, int hi) {
    lds_cptr kb = Kslot + r32 * 128;
    p0 = (f32x16){}; p1 = (f32x16){};
#pragma unroll
    for (int d0 = 0; d0 < 4; ++d0) {
        const bf16x8 b0 = *(const LAS bf16x8*)(kb + kpiece(r32, hi, d0));
        const bf16x8 b1 = *(const LAS bf16x8*)(kb + kpiece(r32, hi, d0) + 4096);
        p0 = __builtin_amdgcn_mfma_f32_32x32x16_bf16(b0, qr[d0], p0, 0, 0, 0);
        p1 = __builtin_amdgcn_mfma_f32_32x32x16_bf16(b1, qr[d0], p1, 0, 0, 0);
    }
}
__device__ __forceinline__ int vlane(int lane) { const int hi = lane >> 5; return ((lane >> 4) & 1) * 32 + (lane & 3) * 8 + (4 * hi + ((lane & 15) >> 2)) * 64; }
template <int NB> __device__ __forceinline__ void pv(f32x16* o, lds_cptr vp, const u32x4& pw0, const u32x4& pw1, const u32x4& pw2, const u32x4& pw3) {
#pragma unroll
    for (int d0 = 0; d0 < NB; ++d0) { s16x4 lo[4], hi[4];
#pragma unroll
        for (int ks = 0; ks < 4; ++ks) { lo[ks] = vtr(vp + d0 * 4096 + ks * 1024); hi[ks] = vtr(vp + d0 * 4096 + ks * 1024 + 512); }
#define AT_PK(k) (bf16x8){lo[k][0], lo[k][1], lo[k][2], lo[k][3], hi[k][0], hi[k][1], hi[k][2], hi[k][3]}
        o[d0] = __builtin_amdgcn_mfma_f32_32x32x16_bf16(__builtin_bit_cast(bf16x8, pw0), AT_PK(0), o[d0], 0, 0, 0);
        o[d0] = __builtin_amdgcn_mfma_f32_32x32x16_bf16(__builtin_bit_cast(bf16x8, pw1), AT_PK(1), o[d0], 0, 0, 0);
        o[d0] = __builtin_amdgcn_mfma_f32_32x32x16_bf16(__builtin_bit_cast(bf16x8, pw2), AT_PK(2), o[d0], 0, 0, 0);
        o[d0] = __builtin_amdgcn_mfma_f32_32x32x16_bf16(__builtin_bit_cast(bf16x8, pw3), AT_PK(3), o[d0], 0, 0, 0);
#undef AT_PK
    }
}
__device__ __forceinline__ void load_k(bf16x8 (&kf)[8], lds_cptr Kslot, int r32, int hi) {
    lds_cptr kb = Kslot + r32 * 128;
#pragma unroll
    for (int d0 = 0; d0 < 4; ++d0) { kf[2 * d0] = *(const LAS bf16x8*)(kb + kpiece(r32, hi, d0)); kf[2 * d0 + 1] = *(const LAS bf16x8*)(kb + kpiece(r32, hi, d0) + 4096); }
}
__device__ __forceinline__ void qkt_r(f32x16& p0, f32x16& p1, const bf16x8 (&kf)[8], const bf16x8* qr) {
    p0 = (f32x16){}; p1 = (f32x16){};
#pragma unroll
    for (int d0 = 0; d0 < 4; ++d0) { p0 = __builtin_amdgcn_mfma_f32_32x32x16_bf16(kf[2 * d0], qr[d0], p0, 0, 0, 0); p1 = __builtin_amdgcn_mfma_f32_32x32x16_bf16(kf[2 * d0 + 1], qr[d0], p1, 0, 0, 0); }
}
__device__ __forceinline__ int vlane2(int lane, int d0) { const int hi = lane >> 5, q = (lane & 15) >> 2; return (4 * hi + q) * 128 + ((d0 ^ ((q >> 1) & 1)) * 64) + ((lane >> 4) & 1) * 32 + (lane & 3) * 8; }
__device__ __forceinline__ int vsrc_piece(int lane) { return ((lane & 7) ^ ((((lane >> 3) >> 1) & 1) << 2)) * 8; }
__device__ __forceinline__ void load_v2(s16x4 (&vlo)[8], s16x4 (&vhi)[8], lds_cptr slot, int va0, int va1) {
#pragma unroll
    for (int d0 = 0; d0 < 2; ++d0)
#pragma unroll
        for (int ks = 0; ks < 4; ++ks) { vlo[d0 * 4 + ks] = vtr(slot + (d0 ? va1 : va0) + ks * 2048); vhi[d0 * 4 + ks] = vtr(slot + (d0 ? va1 : va0) + ks * 2048 + 1024); }
}
__device__ __forceinline__ void pv2_r(f32x16* o, const s16x4 (&vlo)[8], const s16x4 (&vhi)[8], const u32x4& pw0, const u32x4& pw1, const u32x4& pw2, const u32x4& pw3) {
#define AT_PKR(i) (bf16x8){vlo[i][0], vlo[i][1], vlo[i][2], vlo[i][3], vhi[i][0], vhi[i][1], vhi[i][2], vhi[i][3]}
#pragma unroll
    for (int d0 = 0; d0 < 2; ++d0) {
        o[d0] = __builtin_amdgcn_mfma_f32_32x32x16_bf16(__builtin_bit_cast(bf16x8, pw0), AT_PKR(d0 * 4 + 0), o[d0], 0, 0, 0);
        o[d0] = __builtin_amdgcn_mfma_f32_32x32x16_bf16(__builtin_bit_cast(bf16x8, pw1), AT_PKR(d0 * 4 + 1), o[d0], 0, 0, 0);
        o[d0] = __builtin_amdgcn_mfma_f32_32x32x16_bf16(__builtin_bit_cast(bf16x8, pw2), AT_PKR(d0 * 4 + 2), o[d0], 0, 0, 0);
        o[d0] = __builtin_amdgcn_mfma_f32_32x32x16_bf16(__builtin_bit_cast(bf16x8, pw3), AT_PKR(d0 * 4 + 3), o[d0], 0, 0, 0); }
#undef AT_PKR
}
__device__ __forceinline__ void qkt_ri(f32x16& p0, f32x16& p1, const bf16x8 (&kf)[8], const bf16x8* qr, const f32x16& i0, const f32x16& i1) {
    p0 = __builtin_amdgcn_mfma_f32_32x32x16_bf16(kf[0], qr[0], i0, 0, 0, 0); p1 = __builtin_amdgcn_mfma_f32_32x32x16_bf16(kf[1], qr[0], i1, 0, 0, 0);
#pragma unroll
    for (int d0 = 1; d0 < 4; ++d0) { p0 = __builtin_amdgcn_mfma_f32_32x32x16_bf16(kf[2 * d0], qr[d0], p0, 0, 0, 0); p1 = __builtin_amdgcn_mfma_f32_32x32x16_bf16(kf[2 * d0 + 1], qr[d0], p1, 0, 0, 0); }
}
__device__ __forceinline__ float rowmax32(const f32x16& p0, const f32x16& p1) {
    float a = fmaxf(p0[0], p1[0]);
#pragma unroll
    for (int r = 1; r < 16; ++r) a = fmaxf(a, fmaxf(p0[r], p1[r]));
    auto rr = __builtin_amdgcn_permlane32_swap(__float_as_uint(a), __float_as_uint(a), false, false);
    return fmaxf(__uint_as_float(rr[0]), __uint_as_float(rr[1]));
}
template <int NB> __device__ __forceinline__ void softmax_step(f32x16& p0, f32x16& p1, float& m, float& l, f32x16* o, LAS float* wsf, int r32, int hi, u32x4& pw0, u32x4& pw1, u32x4& pw2, u32x4& pw3) {
    const float rm = rowmax32(p0, p1);
    const float mn = fmaxf(m, rm);
    const float alpha = __builtin_amdgcn_exp2f(m - mn);
    m = mn;
    const bool resc = !__all(alpha == 1.f);
    if (resc && hi == 0) wsf[r32] = alpha;
    float s = 0.f;
#pragma unroll
    for (int r = 0; r < 16; ++r) { p0[r] = __builtin_amdgcn_exp2f(p0[r] - mn); p1[r] = __builtin_amdgcn_exp2f(p1[r] - mn); s += p0[r] + p1[r]; }
    l = l * alpha + s;
    pw0 = (u32x4){cvtpk(p0[0], p0[1]), cvtpk(p0[2], p0[3]), cvtpk(p0[4], p0[5]), cvtpk(p0[6], p0[7])};
    pw1 = (u32x4){cvtpk(p0[8], p0[9]), cvtpk(p0[10], p0[11]), cvtpk(p0[12], p0[13]), cvtpk(p0[14], p0[15])};
    pw2 = (u32x4){cvtpk(p1[0], p1[1]), cvtpk(p1[2], p1[3]), cvtpk(p1[4], p1[5]), cvtpk(p1[6], p1[7])};
    pw3 = (u32x4){cvtpk(p1[8], p1[9]), cvtpk(p1[10], p1[11]), cvtpk(p1[12], p1[13]), cvtpk(p1[14], p1[15])};
    if (resc) {
        LDS_WAIT();
#pragma unroll
        for (int g = 0; g < 4; ++g) { const f32x4 a = *(const LAS f32x4*)(wsf + 8 * g + 4 * hi);
#pragma unroll
            for (int d = 0; d < NB; ++d) { o[d][4 * g + 0] *= a[0]; o[d][4 * g + 1] *= a[1]; o[d][4 * g + 2] *= a[2]; o[d][4 * g + 3] *= a[3]; } }
    }
}
template <int NB> __device__ __forceinline__ bool softmax_def(f32x16& p0, f32x16& p1, float& mh, float& l, f32x16* o, LAS float* wsf, int r32, int hi, bool first, u32x4& pw0, u32x4& pw1, u32x4& pw2, u32x4& pw3) {
    const float rm = rowmax32(p0, p1);
    const bool trig = first || __any(rm > 8.f);
    if (trig) {
        const float dl = first ? rm : fmaxf(rm, 0.f);
        mh += dl;
#pragma unroll
        for (int r = 0; r < 16; ++r) { p0[r] -= dl; p1[r] -= dl; }
        if (!first) {
            const float f = __builtin_amdgcn_exp2f(-dl);
            l *= f;
            if (hi == 0) wsf[r32] = f;
            LDS_WAIT();
#pragma unroll
            for (int g = 0; g < 4; ++g) { const f32x4 a = *(const LAS f32x4*)(wsf + 8 * g + 4 * hi);
#pragma unroll
                for (int d = 0; d < NB; ++d) { o[d][4 * g + 0] *= a[0]; o[d][4 * g + 1] *= a[1]; o[d][4 * g + 2] *= a[2]; o[d][4 * g + 3] *= a[3]; } }
        }
    }
    float s = 0.f;
#pragma unroll
    for (int r = 0; r < 16; ++r) { p0[r] = __builtin_amdgcn_exp2f(p0[r]); p1[r] = __builtin_amdgcn_exp2f(p1[r]); s += p0[r] + p1[r]; }
    l += s;
    pw0 = (u32x4){cvtpk(p0[0], p0[1]), cvtpk(p0[2], p0[3]), cvtpk(p0[4], p0[5]), cvtpk(p0[6], p0[7])};
    pw1 = (u32x4){cvtpk(p0[8], p0[9]), cvtpk(p0[10], p0[11]), cvtpk(p0[12], p0[13]), cvtpk(p0[14], p0[15])};
    pw2 = (u32x4){cvtpk(p1[0], p1[1]), cvtpk(p1[2], p1[3]), cvtpk(p1[4], p1[5]), cvtpk(p1[6], p1[7])};
    pw3 = (u32x4){cvtpk(p1[8], p1[9]), cvtpk(p1[10], p1[11]), cvtpk(p1[12], p1[13]), cvtpk(p1[14], p1[15])};
    return trig;
}
__device__ __forceinline__ void row_scales(float l, LAS float* wsf, int r32, int hi, float scale, float (&rl)[16]) {
    auto rr = __builtin_amdgcn_permlane32_swap(__float_as_uint(l), __float_as_uint(l), false, false);
    const float lt = __uint_as_float(rr[0]) + __uint_as_float(rr[1]);
    LDS_WAIT();
    if (hi == 0) wsf[32 + r32] = scale * __builtin_amdgcn_rcpf(lt);
    LDS_WAIT();
#pragma unroll
    for (int g = 0; g < 4; ++g) { const f32x4 a = *(const LAS f32x4*)(wsf + 32 + 8 * g + 4 * hi); rl[4 * g] = a[0]; rl[4 * g + 1] = a[1]; rl[4 * g + 2] = a[2]; rl[4 * g + 3] = a[3]; }
}
}

__device__ __forceinline__ void attn_c_phase(LAS unsigned char* lds, const bf16_t* QKV, const float* rel, bf16_t* ATT, int vcu, int G, int wave, int lane, int tid) {
    using namespace at;
    constexpr int WS_OFF = 98304, OST_OFF = 0;
    const int r32 = lane & 31, hi = lane >> 5;
    const int hh = wave >> 2, cc = (wave >> 1) & 1, rh = wave & 1;
    LAS float* wsf = (LAS float*)(lds + WS_OFF) + wave * 64;
    LAS float* tab = (LAS float*)(lds + TAB_OFF);
    const unsigned lds0 = (unsigned)(uintptr_t)lds;
    const int va0 = vlane2(lane, 0), va1 = vlane2(lane, 1);
    constexpr int NUNIT = BATCH * 8 * 32;
    int cur_hp = -1;
    for (int u = vcu; u < NUNIT; u += G) {
        const int b = u >> 8, hp = (u >> 5) & 7, cp = u & 31;
        if (hp != cur_hp) {
            AT_BAR();
            for (int i = tid; i < 2 * 640; i += NWAVES * 64) { const int h2 = i / 640, idx = i % 640; int d = idx - 63; d = d < -128 ? -128 : (d > 128 ? 128 : d); tab[i] = rel[(d + 128) * 16 + 2 * hp + h2] * LOG2E; }
            cur_hp = hp;
            AT_BAR();
        }
        const int head = 2 * hp + hh, qchunk = 2 * cp + cc;
        const size_t rowbase = (size_t)b * SEQ;
        bf16x8 qr[4];
        { const bf16_t* qp = QKV + (rowbase + qchunk * 64 + 32 * rh + r32) * C_IN + head * 64 + 8 * hi;
#pragma unroll
          for (int d0 = 0; d0 < 4; ++d0) qr[d0] = *(const GAS bf16x8*)(qp + 16 * d0); }
        const int j0 = (2 * cp - 8 < 0) ? (8 - 2 * cp) : 0;
        const bf16_t* ksrc = QKV + (rowbase + 8 * wave + (lane >> 3)) * C_IN + 1024 + (2 * hp) * 64 + ksrc_piece(lane);
        const bf16_t* vsrc = QKV + (rowbase + 8 * wave + (lane >> 3)) * C_IN + 2048 + (2 * hp) * 64 + vsrc_piece(lane);
#define DMA_TILE(j, buf) do { const size_t ro_ = (size_t)((2 * cp - 8 + (j)) * 64) * C_IN; const unsigned d_ = (unsigned)__builtin_amdgcn_readfirstlane(lds0 + (buf) * 32768 + wave * 1024); \
        glds16(ksrc + ro_, d_); glds16(ksrc + ro_ + 64, d_ + 8192); glds16(vsrc + ro_, d_ + 16384); glds16(vsrc + ro_ + 64, d_ + 24576); } while (0)
        float mh = 0.f, l = 0.f; f32x16 o[2]; o[0] = (f32x16){}; o[1] = (f32x16){};
        const float cb = tab[hh * 640 + 63 + 128]; f32x16 cfar; bool first = true;
#pragma unroll
        for (int r = 0; r < 16; ++r) cfar[r] = cb;
        DMA_TILE(j0, 0); if (j0 + 1 < 10) DMA_TILE(j0 + 1, 1);
        int buf = 0; bool have_k = false; bf16x8 kf[8];
        for (int j = j0; j < 10; ++j) {
            AT_WAIT_BAR();
            if (j + 2 < 10) DMA_TILE(j + 2, (buf == 0) ? 2 : buf - 1);
            const int bufn = (buf == 2) ? 0 : buf + 1;
            const bool act = (j >= cc && j <= cc + 8), actn = (j + 1 < 10) && (j + 1 >= cc && j + 1 <= cc + 8);
            if (act) {
                lds_cptr Vs = (lds_cptr)(lds + buf * 32768 + 16384 + hh * 8192);
                if (!have_k) load_k(kf, (lds_cptr)(lds + buf * 32768 + hh * 8192), r32, hi);
                s16x4 vlo[8], vhi[8];
                load_v2(vlo, vhi, Vs, va0, va1);
                const int dl = cc + 8 - j;
                f32x16 p0, p1;
                if (dl >= 3) qkt_ri(p0, p1, kf, qr, cfar, cfar);
                else { const LAS float* tp = tab + hh * 640 + (dl * 64 + 32 * rh + r32 - 4 * hi);
                    f32x16 b0, b1;
#pragma unroll
                    for (int r = 0; r < 16; ++r) { b0[r] = tp[63 - ((r & 3) + 8 * (r >> 2))] - mh; b1[r] = tp[31 - ((r & 3) + 8 * (r >> 2))] - mh; }
                    qkt_ri(p0, p1, kf, qr, b0, b1); }
                if (actn) load_k(kf, (lds_cptr)(lds + bufn * 32768 + hh * 8192), r32, hi);
                u32x4 pw0, pw1, pw2, pw3;
                if (softmax_def<2>(p0, p1, mh, l, o, wsf, r32, hi, first, pw0, pw1, pw2, pw3)) {
#pragma unroll
                    for (int r = 0; r < 16; ++r) cfar[r] = cb - mh; }
                first = false;
                pv2_r(o, vlo, vhi, pw0, pw1, pw2, pw3);
            } else if (actn) load_k(kf, (lds_cptr)(lds + bufn * 32768 + hh * 8192), r32, hi);
            have_k = actn;
            buf = bufn;
        }
#undef DMA_TILE
        float rl[16]; row_scales(l, wsf, r32, hi, 1.f, rl);
        AT_BAR();
        { LAS bf16_t* stg = (LAS bf16_t*)(lds + OST_OFF) + wave * 2048;
#pragma unroll
          for (int r = 0; r < 16; ++r) { const int orow = crow(r, hi);
#pragma unroll
              for (int d0 = 0; d0 < 2; ++d0) stg[orow * 64 + d0 * 32 + r32] = (bf16_t)f2bf(o[d0][r] * rl[r]); }
          LDS_WAIT();
          bf16_t* Ow = ATT + (rowbase + qchunk * 64 + 32 * rh) * D + head * 64;
#pragma unroll
          for (int i = 0; i < 4; ++i) { const int row = i * 8 + (lane >> 3), ch = lane & 7; const u32x4 v = *(const LAS u32x4*)(stg + row * 64 + ch * 8); *(GAS u32x4*)(Ow + (size_t)row * D + ch * 8) = v; } }
        AT_BAR();
    }
}

__device__ __forceinline__ void attn_a_build_tab(LAS unsigned char* lds, const float* t5, int tid) {
    LAS float* tab = (LAS float*)(lds + TAB_OFF);
    for (int i = tid; i < 4 * 768; i += NWAVES * 64) { const int h = i / 768, d = (i % 768) - 63; tab[i] = t5[t5_bucket(-d) * 12 + h] * LOG2E; }
}
__device__ __forceinline__ void attn_a_unit(LAS unsigned char* lds, const bf16_t* PROJ, const float* subln, float lam, bf16_t* ATT, int b, int h, int qb, int wave, int lane) {
    using namespace at;
    constexpr int WS_OFF = 98304, XROW = 132;
    const int r32 = lane & 31, hi = lane >> 5;
    const int mm = wave & 1, rg = wave >> 1;
    LAS float* wsf = (LAS float*)(lds + WS_OFF) + wave * 64;
    const LAS float* tab = (const LAS float*)(lds + TAB_OFF) + h * 768;
    const unsigned lds0 = (unsigned)(uintptr_t)lds;
    const int va0 = vlane2(lane, 0), va1 = vlane2(lane, 1);
    const size_t rowbase = (size_t)b * SEQ;
    const int qw0 = 128 * qb + 32 * rg;
    const int cq = qw0 >> 6;
    const int NT = 2 * qb + 2;
    bf16x8 qr[4];
    { const bf16_t* qp = PROJ + (rowbase + qw0 + r32) * AB_INP + h * 128 + mm * 64 + 8 * hi;
#pragma unroll
      for (int d0 = 0; d0 < 4; ++d0) qr[d0] = *(const GAS bf16x8*)(qp + 16 * d0); }
    const bf16_t* ksrc = PROJ + (rowbase + 8 * wave + (lane >> 3)) * AB_INP + 512 + h * 128 + ksrc_piece(lane);
    const bf16_t* vsrc0 = PROJ + (rowbase + 8 * (wave >> 1) + (lane >> 3)) * AB_INP + 1024 + h * 128 + (wave & 1) * 64 + vsrc_piece(lane);
    const bf16_t* vsrc1 = vsrc0 + (size_t)32 * AB_INP;
#define DMA_TILE(t, buf) do { const size_t ro_ = (size_t)((t) * 64) * AB_INP; const unsigned d_ = (unsigned)__builtin_amdgcn_readfirstlane(lds0 + (buf) * 32768 + wave * 1024); \
        const unsigned dv_ = (unsigned)__builtin_amdgcn_readfirstlane(lds0 + (buf) * 32768 + 16384 + (wave & 1) * 8192 + (wave >> 1) * 1024); \
        glds16(ksrc + ro_, d_); glds16(ksrc + ro_ + 64, d_ + 8192); glds16(vsrc0 + ro_, dv_); glds16(vsrc1 + ro_, dv_ + 4096); } while (0)
    float mh = 0.f, l = 0.f; f32x16 o[4]; o[0] = (f32x16){}; o[1] = (f32x16){}; o[2] = (f32x16){}; o[3] = (f32x16){};
    const float c15 = tab[700];
    bool first = true;
    DMA_TILE(0, 0); DMA_TILE(1, 1);
    int buf = 0;
    for (int t = 0; t < NT; ++t) {
        if (t + 1 < NT) asm volatile("s_waitcnt vmcnt(4) lgkmcnt(0)\n\ts_barrier" ::: "memory"); else AT_WAIT_BAR();
        if (t + 2 < NT) DMA_TILE(t + 2, (buf == 0) ? 2 : buf - 1);
        if (t <= cq) {
            lds_cptr Vs = (lds_cptr)(lds + buf * 32768 + 16384);
            f32x16 p0, p1;
            { bf16x8 kf[8];
              load_k(kf, (lds_cptr)(lds + buf * 32768 + mm * 8192), r32, hi);
              const int dmin = qw0 - (64 * t + 63);
              f32x16 b0, b1;
              if (dmin >= 559) { const float c = c15 - mh;
#pragma unroll
                  for (int r = 0; r < 16; ++r) b0[r] = c;
                  qkt_ri(p0, p1, kf, qr, b0, b0); }
              else { const LAS float* tp = tab + (qw0 - 64 * t + r32 - 4 * hi);
#pragma unroll
                  for (int r = 0; r < 16; ++r) { b0[r] = tp[63 - ((r & 3) + 8 * (r >> 2))] - mh; b1[r] = tp[31 - ((r & 3) + 8 * (r >> 2))] - mh; }
                  qkt_ri(p0, p1, kf, qr, b0, b1); } }
            s16x4 vlo[8], vhi[8];
            load_v2(vlo, vhi, Vs, va0, va1);
            u32x4 pw0, pw1, pw2, pw3;
            (void)softmax_def<4>(p0, p1, mh, l, o, wsf, r32, hi, first, pw0, pw1, pw2, pw3);
            first = false;
            pv2_r(o, vlo, vhi, pw0, pw1, pw2, pw3);
            load_v2(vlo, vhi, Vs + 8192, va0, va1);
            pv2_r(o + 2, vlo, vhi, pw0, pw1, pw2, pw3);
        }
        buf = (buf == 2) ? 0 : buf + 1;
    }
#undef DMA_TILE
    float rl[16]; row_scales(l, wsf, r32, hi, mm ? -lam : 1.f, rl);
    LAS float* X = (LAS float*)lds + rg * (32 * XROW);
    AT_BAR();
    if (mm == 1) {
#pragma unroll
        for (int blk = 0; blk < 4; ++blk)
#pragma unroll
            for (int r = 0; r < 16; ++r) X[crow(r, hi) * XROW + blk * 32 + r32] = o[blk][r] * rl[r];
    }
    AT_BAR();
    if (mm == 0) {
#pragma unroll
        for (int blk = 0; blk < 4; ++blk)
#pragma unroll
            for (int r = 0; r < 16; ++r) X[crow(r, hi) * XROW + blk * 32 + r32] += o[blk][r] * rl[r];
        LDS_WAIT();
        const int row = lane >> 1, half = lane & 1;
        const LAS float* xr = X + row * XROW + half * 64;
        f32x4 v[16]; float ss = 0.f;
#pragma unroll
        for (int k = 0; k < 16; ++k) { v[k] = *(const LAS f32x4*)(xr + 4 * k); ss += (v[k][0] * v[k][0] + v[k][1] * v[k][1]) + (v[k][2] * v[k][2] + v[k][3] * v[k][3]); }
        ss += __shfl_xor(ss, 1);
        const float sc = __builtin_amdgcn_rsqf(ss * (1.f / 128.f) + EPS) * 0.8f;
        bf16_t* op = ATT + (rowbase + qw0 + row) * D + h * 128 + half * 64;
        const float* sg = subln + half * 64;
#pragma unroll
        for (int k = 0; k < 8; ++k) { const f32x4 g0 = *(const GAS f32x4*)(sg + 8 * k), g1 = *(const GAS f32x4*)(sg + 8 * k + 4); const f32x4 a = v[2 * k] * sc * g0, c = v[2 * k + 1] * sc * g1;
            u32x4 w; w.x = cvt_pk_bf16(a[0], a[1]); w.y = cvt_pk_bf16(a[2], a[3]); w.z = cvt_pk_bf16(c[0], c[1]); w.w = cvt_pk_bf16(c[2], c[3]);
            *(GAS u32x4*)(op + 8 * k) = w; }
    }
    AT_BAR();
}
__device__ __forceinline__ void attn_a_phase(LAS unsigned char* lds, const bf16_t* PROJ, const float* t5, const float* subln, float lam, bf16_t* ATT, int vcu, int G, int wave, int lane, int tid) {
    AT_BAR();
    attn_a_build_tab(lds, t5, tid);
    AT_BAR();
    for (int p = vcu; p < 512; p += G) {
        const int bh = p >> 4, s = p & 15;
#pragma unroll 1
        for (int k = 0; k < 2; ++k) attn_a_unit(lds, PROJ, subln, lam, ATT, bh >> 2, bh & 3, k ? 31 - s : s, wave, lane);
    }
}

#ifndef BM_SELREP
#define BM_SELREP 1
#endif
#ifndef BM_ATTREP
#define BM_ATTREP 1
#endif
namespace bm {
using namespace at;
constexpr int GT_OFF = 0, EQ_OFF = 16384, CAND_OFF = 32768, CCNT_OFF = 32768 + 4096, SEL_OFF = 98304, VIMG_OFF = 0, QI_OFF = TAB_OFF + 10240, LOINV_OFF = TAB_OFF + 26624;
__device__ __forceinline__ unsigned sortable(float f) { const unsigned u = __float_as_uint(f); return (u & 0x80000000u) ? ~u : (u | 0x80000000u); }
__device__ __forceinline__ void load_kf(bf16x8 (&kf)[4], const bf16_t* kbase, int wave, int i, int r32, int hi) {
    const bf16_t* kp = kbase + (size_t)(64 * (wave + 8 * (i >> 1)) + 32 * (i & 1) + r32) * AB_INP + 8 * hi;
#pragma unroll
    for (int d0 = 0; d0 < 4; ++d0) kf[d0] = *(const GAS bf16x8*)(kp + 16 * d0);
}
__device__ __forceinline__ void half_scores(f32x16& a, const bf16x8 (&kf)[4], lds_cptr qfl, const float (&wq)[4]) {
    a = (f32x16){};
#pragma unroll
    for (int hh = 0; hh < 4; ++hh) { f32x16 p = (f32x16){};
#pragma unroll
        for (int d0 = 0; d0 < 4; ++d0) p = __builtin_amdgcn_mfma_f32_32x32x16_bf16(kf[d0], *(const LAS bf16x8*)(qfl + (hh * 4 + d0) * 1024), p, 0, 0, 0);
#pragma unroll
        for (int r = 0; r < 16; ++r) a[r] = __builtin_fmaf(fmaxf(p[r], 0.f), wq[hh], a[r]);
        __builtin_amdgcn_sched_barrier(0); }
}
__device__ __forceinline__ float unsortable(unsigned k) { return __uint_as_float((k & 0x80000000u) ? (k & 0x7fffffffu) : ~k); }
__device__ __forceinline__ int linbin0(float a, float lo, float invw) { int b = (int)((a - lo) * invw); b = b < 1 ? 1 : b; return b > 2046 ? 2046 : b; }
__device__ __forceinline__ int linbin(float a, float lo, float invw, int zb) { const int b = linbin0(a, lo, invw); return a > 0.f ? (b > zb ? b : zb) + 1 : (a == 0.f ? zb : (b < zb ? b : zb) - 1); }
__device__ __forceinline__ void unit(LAS unsigned char* lds, volatile LAS unsigned* MISC, const bf16_t* PROJ, bf16_t* ATT, unsigned* kc, int b, int qg, int wave, int lane_in, int tid_in) {
    const size_t rowbase = (size_t)b * SEQ;
    const int q0 = 32 * qg, ntile = (q0 >> 6) + 1, nk = 64 * ntile;
    const bf16_t* kbase = PROJ + rowbase * AB_INP + 2432;
    LAS unsigned short* sel = (LAS unsigned short*)(lds + SEL_OFF);
    LAS unsigned* hist = (LAS unsigned*)lds;
    const int ns = nk < 256 ? nk : 256;
    AT_BAR();
    __builtin_amdgcn_fence(__ATOMIC_ACQUIRE, "agent");
    bool fast = false;
    PT_BEGIN(1)
    PT_BEGIN(5)
    if (ntile > 4) {
        float wq[4];
        { const int r32 = lane_in & 31; const bf16_t* qp = PROJ + (rowbase + q0 + r32) * AB_INP;
#pragma unroll
          for (int hh = 0; hh < 4; ++hh) wq[hh] = bf2f(qp[2496 + hh]) * 0.0625f;
#pragma unroll
          for (int i = 0; i < 2; ++i) { const int pc = tid_in + 512 * i, q = pc & 31, hi2 = (pc >> 5) & 1, f = pc >> 6;
              *(LAS u32x4*)(lds + QI_OFF + pc * 16) = *(const GAS u32x4*)(PROJ + (rowbase + q0 + q) * AB_INP + 2176 + (f >> 2) * 64 + 16 * (f & 3) + 8 * hi2); }
#pragma unroll 1
          for (int i = 0; i < 16; ++i) *(LAS u32x4*)(lds + (i * 512 + tid_in) * 16) = (u32x4){0u, 0u, 0u, 0u};
          if (tid_in < 32) { MISC[128 + 2 * tid_in] = 0u; MISC[129 + 2 * tid_in] = 256u; }
          if (tid_in == 0) { MISC[248] = 0u; MISC[249] = 0u; } }
        AT_BAR();
        PT_END(1)
        PT_BEGIN(2)
        { int tid = tid_in, lane = lane_in; asm volatile("" : "+v"(tid), "+v"(lane));
          const int r32 = lane & 31, hi = lane >> 5;
          LAS unsigned* hq = hist + r32 * 1024;
          lds_cptr qfl = (lds_cptr)(lds + QI_OFF + hi * 512 + r32 * 16);
          const int nhalf = 2 * ((ntile - wave + NWAVES - 1) / NWAVES);
          GAS u32x4* kcw = (GAS u32x4*)kc + (size_t)(wave * 16) * 256 + lane;
          bf16x8 kf3[4][4];
          if (nhalf > 0) load_kf(kf3[0], kbase, wave, 0, r32, hi);
          if (nhalf > 1) load_kf(kf3[1], kbase, wave, 1, r32, hi);
          if (nhalf > 2) load_kf(kf3[2], kbase, wave, 2, r32, hi);
#pragma unroll 1
          for (int i0 = 0; i0 < nhalf; i0 += 4) {
#pragma unroll
              for (int u = 0; u < 4; ++u) { const int i = i0 + u;
                  if (i < nhalf) {
                      if (i + 3 < nhalf) load_kf(kf3[(u + 3) & 3], kbase, wave, i + 3, r32, hi);
                      f32x16 a;
                      half_scores(a, kf3[u], qfl, wq);
                      unsigned k[16];
#pragma unroll
                      for (int r = 0; r < 16; ++r) k[r] = sortable(a[r]);
#pragma unroll
                      for (int r4 = 0; r4 < 4; ++r4) kcw[(i * 4 + r4) * 64] = (u32x4){k[4 * r4], k[4 * r4 + 1], k[4 * r4 + 2], k[4 * r4 + 3]};
#pragma unroll
                      for (int r = 0; r < 16; ++r) { const unsigned bin = k[r] >> 21; (void)__hip_atomic_fetch_add(hq + (bin >> 1), 1u << ((bin & 1u) << 4), __ATOMIC_RELAXED, __HIP_MEMORY_SCOPE_WORKGROUP); }
                  } }
          } }
        AT_BAR();
        PT_END(2)
#define BM_SCAN(PASSV) do { const int q = tid >> 4, j = tid & 15; const LAS unsigned* hq0 = hist + q * 1024; const LAS unsigned* hqq = hq0 + (1024 - 64 * (j + 1)); \
            unsigned c = 0; \
            _Pragma("unroll 8") for (int d = 0; d < 64; ++d) { const unsigned w = hqq[(d + 4 * j + q) & 63]; c += (w & 0xffffu) + (w >> 16); } \
            unsigned cum = c; \
            _Pragma("unroll") for (int off = 1; off < 16; off <<= 1) { const unsigned tt = __shfl_up(cum, off, 16); if (j >= off) cum += tt; } \
            const unsigned need = MISC[129 + 2 * q], before = cum - c; \
            const bool own = (before < need && need <= cum); \
            const unsigned long long bal = __ballot(own); const int jstar = __builtin_ctzll((bal >> (tid & 48)) & 0xffffull); \
            const unsigned before_s = __shfl(before, jstar, 16); \
            const LAS unsigned* hqs = hq0 + (1024 - 64 * (jstar + 1)) + (60 - 4 * j);            \
            const u32x4 w4 = *(const LAS u32x4*)hqs; \
            const unsigned b7 = w4.w >> 16, b6 = w4.w & 0xffffu, b5 = w4.z >> 16, b4 = w4.z & 0xffffu, b3 = w4.y >> 16, b2 = w4.y & 0xffffu, b1 = w4.x >> 16, b0 = w4.x & 0xffffu;     \
            const unsigned c2 = ((b7 + b6) + (b5 + b4)) + ((b3 + b2) + (b1 + b0)); \
            unsigned cum2 = c2; \
            _Pragma("unroll") for (int off = 1; off < 16; off <<= 1) { const unsigned tt = __shfl_up(cum2, off, 16); if (j >= off) cum2 += tt; } \
            const unsigned bef2 = before_s + cum2 - c2; \
            if (bef2 < need && need <= bef2 + c2) { \
                const unsigned bv[8] = {b7, b6, b5, b4, b3, b2, b1, b0}; unsigned run = bef2, T = 0, nn = need, cT = 0; bool found = false; \
                const unsigned bintop = 2u * (unsigned)(1024 - 64 * (jstar + 1) + 63 - 4 * j) + 1u;                                       \
                _Pragma("unroll") for (int m = 0; m < 8; ++m) { if (!found) { if (run + bv[m] >= need) { T = bintop - m; nn = need - run; cT = bv[m]; found = true; } else run += bv[m]; } } \
                const unsigned prf = MISC[128 + 2 * q]; \
                MISC[128 + 2 * q] = ((PASSV) <= 0) ? T : ((prf << ((PASSV) == 1 ? 11 : 10)) | T); MISC[129 + 2 * q] = nn; \
                if ((PASSV) == 1) { const unsigned t22_ = (prf << 11) | T; const bool zb_ = (cT > 16u) && (t22_ == 0x200000u);        \
                    MISC[192 + q] = zb_ ? (0x10000u | cT) : cT; if (cT > 16u && !zb_) MISC[248] = 1u; } } } while (0)
        PT_BEGIN(6)
        { int tid = tid_in; asm volatile("" : "+v"(tid)); BM_SCAN(0); }
        AT_BAR();
        PT_END(6)
        PT_BEGIN(7)
#pragma unroll 1
        for (int pass = 1; pass < 4; ++pass) {
            if (pass == 2 && fast) break;
            const unsigned shift = pass == 0 ? 21u : (pass == 1 ? 10u : 0u), bmask = pass == 2 ? 1023u : 2047u, cshift = pass == 1 ? 21u : 10u;
            int tid = tid_in, lane = lane_in; asm volatile("" : "+v"(tid), "+v"(lane));
            const int r32 = lane & 31, hi = lane >> 5;
            AT_BAR();
            if (pass < 3) {
#pragma unroll 1
                for (int i = 0; i < 16; ++i) *(LAS u32x4*)(lds + (i * 512 + tid) * 16) = (u32x4){0u, 0u, 0u, 0u};
            }
            AT_BAR();
            const unsigned pref = MISC[128 + 2 * r32];
            LAS unsigned* hq = hist + r32 * 1024;
            const int nhalf = 2 * ((ntile - wave + NWAVES - 1) / NWAVES);
            GAS u32x4* kcw = (GAS u32x4*)kc + (size_t)(wave * 16) * 256 + lane;
            {
                u32x4 kq[4], kqn[4];
                if (nhalf > 0) {
#pragma unroll
                    for (int r4 = 0; r4 < 4; ++r4) kq[r4] = kcw[r4 * 64]; }
                unsigned gm0 = 0u, em0 = 0u;
#pragma unroll 1
                for (int i = 0; i < nhalf; ++i) {
                    const int t = wave + 8 * (i >> 1), sh = i & 1;
                    if (i + 1 < nhalf) {
#pragma unroll
                        for (int r4 = 0; r4 < 4; ++r4) kqn[r4] = kcw[((i + 1) * 4 + r4) * 64]; }
                    if (pass < 3) {
#pragma unroll
                        for (int r = 0; r < 16; ++r) { const unsigned key = kq[r >> 2][r & 3], bin = (key >> shift) & bmask;
                            if ((key >> cshift) == pref) (void)__hip_atomic_fetch_add(hq + (bin >> 1), 1u << ((bin & 1u) << 4), __ATOMIC_RELAXED, __HIP_MEMORY_SCOPE_WORKGROUP); }
                    } else {
                        unsigned g_ = 0u, e_ = 0u;
#pragma unroll
                        for (int r = 0; r < 16; ++r) { const unsigned key = kq[r >> 2][r & 3], bit = 1u << ((r & 3) + 8 * (r >> 2)); g_ |= (key > pref) ? bit : 0u; e_ |= (key == pref) ? bit : 0u; }
                        if (sh == 0) { gm0 = g_; em0 = e_; }
                        else {
                            unsigned glo = gm0 << (4 * hi), ghi = g_ << (4 * hi), elo = em0 << (4 * hi), ehi = e_ << (4 * hi);
                            glo |= __shfl_xor(glo, 32); ghi |= __shfl_xor(ghi, 32); elo |= __shfl_xor(elo, 32); ehi |= __shfl_xor(ehi, 32);
                            if (hi == 0) { *(LAS u32x2*)(lds + GT_OFF + (r32 * 64 + t) * 8) = (u32x2){glo, ghi}; *(LAS u32x2*)(lds + EQ_OFF + (r32 * 64 + t) * 8) = (u32x2){elo, ehi}; }
                        }
                    }
#pragma unroll
                    for (int r4 = 0; r4 < 4; ++r4) kq[r4] = kqn[r4];
                }
            }
            AT_BAR();
            if (pass < 3) { BM_SCAN(pass); AT_BAR(); }
            if (pass == 1 && MISC[248] == 0u) {
                fast = true;
            { int tid = tid_in, lane = lane_in; asm volatile("" : "+v"(tid), "+v"(lane));
              const int r32 = lane & 31, hi = lane >> 5;
              if (tid < 32) ((LAS unsigned*)(lds + CCNT_OFF))[tid] = 0u;
              AT_BAR();
              const unsigned T22 = MISC[128 + 2 * r32]; const bool tieq = (MISC[192 + r32] >> 16) != 0u;
              const int nhalf = 2 * ((ntile - wave + NWAVES - 1) / NWAVES);
              GAS u32x4* kcw = (GAS u32x4*)kc + (size_t)(wave * 16) * 256 + lane;
              u32x4 kq[4], kqn[4];
              if (nhalf > 0) {
#pragma unroll
                  for (int r4 = 0; r4 < 4; ++r4) kq[r4] = kcw[r4 * 64]; }
              unsigned gm0 = 0u, em0 = 0u;
#pragma unroll 1
              for (int i = 0; i < nhalf; ++i) {
                  const int t = wave + 8 * (i >> 1), sh = i & 1;
                  if (i + 1 < nhalf) {
#pragma unroll
                      for (int r4 = 0; r4 < 4; ++r4) kqn[r4] = kcw[((i + 1) * 4 + r4) * 64]; }
                  unsigned g_ = 0u, e_ = 0u;
#pragma unroll
                  for (int r = 0; r < 16; ++r) { const unsigned key = kq[r >> 2][r & 3], bn = key >> 10; const unsigned bit = 1u << ((r & 3) + 8 * (r >> 2));
                      g_ |= (bn > T22) ? bit : 0u;
                      if (bn == T22) {
                          if (tieq) {
                              if (key == 0x80000000u) e_ |= bit; else { g_ |= bit; (void)__hip_atomic_fetch_add((LAS unsigned*)(lds + CCNT_OFF) + r32, 1u, __ATOMIC_RELAXED, __HIP_MEMORY_SCOPE_WORKGROUP); } }
                          else { const unsigned slot = __hip_atomic_fetch_add((LAS unsigned*)(lds + CCNT_OFF) + r32, 1u, __ATOMIC_RELAXED, __HIP_MEMORY_SCOPE_WORKGROUP);
                              if (slot < 16u) *(LAS u32x2*)(lds + CAND_OFF + (r32 * 16 + slot) * 8) = (u32x2){key, (unsigned)(64 * t + 32 * sh + (r & 3) + 8 * (r >> 2) + 4 * hi)}; } } }
                  if (sh == 0) { gm0 = g_; em0 = e_; }
                  else { unsigned glo = gm0 << (4 * hi), ghi = g_ << (4 * hi), elo = em0 << (4 * hi), ehi = e_ << (4 * hi);
                      glo |= __shfl_xor(glo, 32); ghi |= __shfl_xor(ghi, 32); elo |= __shfl_xor(elo, 32); ehi |= __shfl_xor(ehi, 32);
                      if (hi == 0) { *(LAS u32x2*)(lds + GT_OFF + (r32 * 64 + t) * 8) = (u32x2){glo, ghi}; *(LAS u32x2*)(lds + EQ_OFF + (r32 * 64 + t) * 8) = (u32x2){elo, ehi}; } }
#pragma unroll
                  for (int r4 = 0; r4 < 4; ++r4) kq[r4] = kqn[r4];
              } }
            AT_BAR();
            { int tid = tid_in; asm volatile("" : "+v"(tid)); const int q = tid >> 4, j = tid & 15;
              const unsigned c0w = MISC[192 + q], need = MISC[129 + 2 * q]; const bool tq = (c0w >> 16) != 0u; const unsigned c0 = tq ? 0u : c0w;
              if (tq && j == 0) { const unsigned cp_ = ((const LAS unsigned*)(lds + CCNT_OFF))[q]; if (cp_ > need) MISC[249] = 1u; else MISC[192 + q] = 0x10000u | (need - cp_); }
              if ((unsigned)j < c0) { const u32x2 my = *(const LAS u32x2*)(lds + CAND_OFF + (q * 16 + j) * 8); unsigned rank = 0;
#pragma unroll 1
                  for (unsigned i = 0; i < c0; ++i) { const u32x2 ot = *(const LAS u32x2*)(lds + CAND_OFF + (q * 16 + i) * 8); rank += (ot.x > my.x || (ot.x == my.x && ot.y < my.y)) ? 1u : 0u; }
                  if (rank < need) (void)__hip_atomic_fetch_or((LAS unsigned*)(lds + GT_OFF + (q * 64 + (my.y >> 6)) * 8 + 4 * ((my.y >> 5) & 1u)), 1u << (my.y & 31u), __ATOMIC_RELAXED, __HIP_MEMORY_SCOPE_WORKGROUP); } }
            AT_BAR();
                if (MISC[249] != 0u) fast = false;
            }
        }
#undef BM_SCAN
        PT_BEGIN(9)
        { int tid = tid_in; asm volatile("" : "+v"(tid)); const int q = tid >> 4, j = tid & 15; const unsigned need_eq = fast ? (((MISC[192 + q] >> 16) != 0u) ? (MISC[192 + q] & 0xffffu) : 0u) : MISC[129 + 2 * q];
          unsigned long long g[4], e[4]; unsigned ce = 0;
#pragma unroll
          for (int i = 0; i < 4; ++i) { const int t = 4 * j + i; g[i] = 0ull; e[i] = 0ull;
              if (t < ntile) { const u32x2 a = *(const LAS u32x2*)(lds + GT_OFF + (q * 64 + t) * 8), c = *(const LAS u32x2*)(lds + EQ_OFF + (q * 64 + t) * 8);
                  g[i] = ((unsigned long long)a.y << 32) | a.x; e[i] = ((unsigned long long)c.y << 32) | c.x; }
              ce += (unsigned)__builtin_popcountll(e[i]); }
          unsigned cum = ce;
#pragma unroll
          for (int off = 1; off < 16; off <<= 1) { const unsigned tt = __shfl_up(cum, off, 16); if (j >= off) cum += tt; }
          int allowed = (int)need_eq - (int)(cum - ce);
          unsigned cs = 0;
#pragma unroll
          for (int i = 0; i < 4; ++i) { unsigned long long x = e[i]; const int pc = __builtin_popcountll(x);
              if (allowed <= 0) x = 0ull; else if (pc > allowed) { int drop = pc - allowed; while (drop > 0) { x &= ~(1ull << (63 - __builtin_clzll(x))); --drop; } }
              allowed -= pc; g[i] |= x; cs += (unsigned)__builtin_popcountll(g[i]); }
          unsigned cum2 = cs;
#pragma unroll
          for (int off = 1; off < 16; off <<= 1) { const unsigned tt = __shfl_up(cum2, off, 16); if (j >= off) cum2 += tt; }
          unsigned pos = cum2 - cs;
          LAS unsigned short* sq = sel + q * 256;
#pragma unroll
          for (int i = 0; i < 4; ++i) { unsigned long long x = g[i]; const int t = 4 * j + i;
              while (x) { const int bpos = __builtin_ctzll(x); x &= x - 1; if (pos < 256u) sq[pos] = (unsigned short)(64 * t + bpos); ++pos; } } }
        PT_END(9)
    } else {
        for (int i = tid_in; i < 32 * 256; i += NWAVES * 64) { const int k = i & 255; sel[i] = (unsigned short)(k < nk ? k : 0); }
    }
    AT_BAR();
    PT_END(5)
    PT_BEGIN(4)
    int lane = lane_in; asm volatile("" : "+v"(lane));
    const int c = lane & 15, g = lane >> 4;
    const LAS bf16_t* tabB = (const LAS bf16_t*)(lds + TAB_OFF);
    const unsigned lds0 = (unsigned)(uintptr_t)lds;
    LAS unsigned char* vimg = lds + VIMG_OFF + wave * 12288;
    const unsigned vdst = (unsigned)__builtin_amdgcn_readfirstlane(lds0 + VIMG_OFF + wave * 12288);
    const bf16_t* kvb = PROJ + rowbase * AB_INP + 2048;
    const LAS unsigned short* selw = sel + (4 * wave) * 256;
#define BM_KLOAD(dst, s_) do { const int e_ = 32 * (s_) + c; const int k0_ = selw[e_], k1_ = selw[e_ + 16]; \
        const bf16_t* p0_ = kvb + (size_t)k0_ * AB_INP + 8 * g; const bf16_t* p1_ = kvb + (size_t)k1_ * AB_INP + 8 * g; \
        dst[0] = *(const GAS bf16x8*)p0_; dst[1] = *(const GAS bf16x8*)(p0_ + 32); dst[2] = *(const GAS bf16x8*)p1_; dst[3] = *(const GAS bf16x8*)(p1_ + 32); } while (0)
#define BM_VDMA(s_) do { _Pragma("unroll") for (int n_ = 0; n_ < 4; ++n_) { const int kidx_ = selw[32 * (s_) + 8 * n_ + (lane >> 3)]; \
        glds16(kvb + (size_t)kidx_ * AB_INP + 64 + 8 * (lane & 7), vdst + ((s_) % 3) * 4096 + n_ * 1024); } } while (0)
    bf16x8 kr[4][4];
    BM_KLOAD(kr[0], 0); BM_KLOAD(kr[1], 1); BM_KLOAD(kr[2], 2); BM_KLOAD(kr[3], 3);
    BM_VDMA(0); BM_VDMA(1);
    bf16x8 qb0 = (bf16x8){}, qb1 = (bf16x8){};
    float mh = 0.f, l = 0.f;
    f32x4 o[4] = {(f32x4){0.f, 0.f, 0.f, 0.f}, (f32x4){0.f, 0.f, 0.f, 0.f}, (f32x4){0.f, 0.f, 0.f, 0.f}, (f32x4){0.f, 0.f, 0.f, 0.f}};
#pragma unroll 1
    for (int s0 = 0; s0 < 32; s0 += 4) {
#pragma unroll
        for (int u = 0; u < 4; ++u) {
            const int s = s0 + u, qi = s >> 3, ch = s & 7, q = q0 + 4 * wave + qi;
            const bool first = (ch == 0);
            if (first) {
                qb0 = (bf16x8){}; qb1 = (bf16x8){};
                if (c < 8) { const bf16_t* qp = PROJ + (rowbase + q) * AB_INP + 1536 + c * 64 + 8 * g; qb0 = *(const GAS bf16x8*)qp; qb1 = *(const GAS bf16x8*)(qp + 32); }
                mh = 0.f; l = 0.f;
#pragma unroll
                for (int nt = 0; nt < 4; ++nt) o[nt] = (f32x4){0.f, 0.f, 0.f, 0.f};
            }
            if (s + 2 < 32) BM_VDMA(s + 2);
            f32x4 sa = (f32x4){0.f, 0.f, 0.f, 0.f}, sb = (f32x4){0.f, 0.f, 0.f, 0.f};
            sa = __builtin_amdgcn_mfma_f32_16x16x32_bf16(kr[u][0], qb0, sa, 0, 0, 0); sa = __builtin_amdgcn_mfma_f32_16x16x32_bf16(kr[u][1], qb1, sa, 0, 0, 0);
            sb = __builtin_amdgcn_mfma_f32_16x16x32_bf16(kr[u][2], qb0, sb, 0, 0, 0); sb = __builtin_amdgcn_mfma_f32_16x16x32_bf16(kr[u][3], qb1, sb, 0, 0, 0);
            if (s + 4 < 32) BM_KLOAD(kr[u], s + 4);
            const u32x2 wa = *(const LAS u32x2*)(selw + 32 * s + 4 * g), wb = *(const LAS u32x2*)(selw + 32 * s + 16 + 4 * g);
            const int ka[4] = {(int)(wa.x & 0xffffu), (int)(wa.x >> 16), (int)(wa.y & 0xffffu), (int)(wa.y >> 16)}, kb4[4] = {(int)(wb.x & 0xffffu), (int)(wb.x >> 16), (int)(wb.y & 0xffffu), (int)(wb.y >> 16)};
            float lm = -1e30f;
#pragma unroll
            for (int i = 0; i < 4; ++i) {
                int da = q - ka[i]; da = da > 559 ? 559 : da; int db = q - kb4[i]; db = db > 559 ? 559 : db;
                const float va = (32 * ch + 4 * g + i < ns) ? sa[i] + bf2f(tabB[(da + 63) * 8 + (c & 7)]) - mh : -1e30f;
                const float vb2 = (32 * ch + 16 + 4 * g + i < ns) ? sb[i] + bf2f(tabB[(db + 63) * 8 + (c & 7)]) - mh : -1e30f;
                sa[i] = va; sb[i] = vb2; lm = fmaxf(lm, fmaxf(va, vb2)); }
            if (first || __any(lm > 8.f)) {
                float rm = fmaxf(lm, __shfl_xor(lm, 16)); rm = fmaxf(rm, __shfl_xor(rm, 32));
                const float dl = first ? rm : fmaxf(rm, 0.f);
                mh += dl;
#pragma unroll
                for (int i = 0; i < 4; ++i) { sa[i] -= dl; sb[i] -= dl; }
                if (!first) { const float f = __builtin_amdgcn_exp2f(-dl); l *= f;
#pragma unroll
                    for (int i = 0; i < 4; ++i) { const float fi = __shfl(f, 4 * g + i);
#pragma unroll
                        for (int nt = 0; nt < 4; ++nt) o[nt][i] *= fi; } }
            }
#pragma unroll
            for (int i = 0; i < 4; ++i) { sa[i] = __builtin_amdgcn_exp2f(sa[i]); sb[i] = __builtin_amdgcn_exp2f(sb[i]); l += sa[i] + sb[i]; }
            const u32x4 pw = (u32x4){cvtpk(sa[0], sa[1]), cvtpk(sa[2], sa[3]), cvtpk(sb[0], sb[1]), cvtpk(sb[2], sb[3])};
            if (s0 != 28 || u == 0) asm volatile("s_waitcnt vmcnt(16)" ::: "memory");
            else if (u == 1) asm volatile("s_waitcnt vmcnt(12)" ::: "memory");
            else if (u == 2) asm volatile("s_waitcnt vmcnt(4)" ::: "memory");
            else asm volatile("s_waitcnt vmcnt(0)" ::: "memory");
            lds_cptr vb = (lds_cptr)vimg + (s % 3) * 4096 + (4 * g + (c >> 2)) * 128 + 8 * (c & 3);
#pragma unroll
            for (int nt = 0; nt < 4; ++nt) { const s16x4 lo = vtr(vb + 32 * nt), hi4 = vtr(vb + 16 * 128 + 32 * nt);
                const bf16x8 vf = (bf16x8){lo[0], lo[1], lo[2], lo[3], hi4[0], hi4[1], hi4[2], hi4[3]};
                o[nt] = __builtin_amdgcn_mfma_f32_16x16x32_bf16(__builtin_bit_cast(bf16x8, pw), vf, o[nt], 0, 0, 0); }
            LDS_WAIT();
            if (ch == 7) {
                float lt = l + __shfl_xor(l, 16); lt += __shfl_xor(lt, 32);
                const float linv = __builtin_amdgcn_rcpf(lt);
                if (g < 2) { bf16_t* op = ATT + (rowbase + q) * D + 512 + c;
#pragma unroll
                    for (int i = 0; i < 4; ++i) { const float li = __shfl(linv, 4 * g + i);
#pragma unroll
                        for (int nt = 0; nt < 4; ++nt) op[(4 * g + i) * 64 + 16 * nt] = (bf16_t)f2bf(o[nt][i] * li); } }
            }
        }
    }
    asm volatile("s_waitcnt vmcnt(0)" ::: "memory");
    PT_END(4)
#undef BM_KLOAD
#undef BM_VDMA
}
}
__device__ __forceinline__ void attn_b_phase(LAS unsigned char* lds, volatile LAS unsigned* MISC, const bf16_t* PROJ, const float* t5, bf16_t* ATT, unsigned* kc, int vcu, int G, int wave, int lane, int tid) {
    AT_BAR();
    { LAS bf16_t* tab = (LAS bf16_t*)(lds + TAB_OFF);
      for (int i = tid; i < 640 * 8; i += NWAVES * 64) { const int idx = i >> 3, h = i & 7; const int d = idx - 63; tab[i] = (bf16_t)f2bf(t5[t5_bucket(-d) * 12 + 4 + h] * LOG2E); } }
    AT_BAR();
    for (int p = vcu; p < 512; p += G) {
        const int b = p >> 6, s = p & 63;
#pragma unroll 1
        for (int k = 0; k < 2; ++k) bm::unit(lds, MISC, PROJ, ATT, kc, b, k ? 127 - s : s, wave, lane, tid);
    }
}
#ifndef NAIVE_B
#define NAIVE_B 0
#endif
#ifndef XBAR
#define XBAR 0
#endif
#ifndef DUP
#define DUP 0
#endif
struct Args { const float* in[19]; float* out; unsigned char* ws; int ph_lo, ph_hi, li, pad; };
static_assert(sizeof(Args) == 19 * 8 + 8 + 8 + 16, "Args has no padding");

__global__ void __launch_bounds__(NWAVES * 64, 2) mk_fwd(Args args) {
    extern __shared__ __attribute__((aligned(16))) unsigned char lds_raw[];
    LAS unsigned char* lds = (LAS unsigned char*)lds_raw;
    volatile LAS unsigned* MISC = (volatile LAS unsigned*)(lds + MISC_OFF);
    const int tid = threadIdx.x, lane = tid & 63, wave = __builtin_amdgcn_readfirstlane(tid >> 6);
    const int G = gridDim.x; const int bx = blockIdx.x;
    const int vcu = (G % 8 == 0) ? (bx % 8) * (G / 8) + bx / 8 : bx;
    unsigned char* ws = args.ws;
    unsigned* ctl = (unsigned*)(ws + WS_CTL);
    const float* x = args.in[0]; const float* t5 = args.in[1]; const float* ln_mix = args.in[2]; const float* ln_ffn = args.in[3]; const float* ln_final = args.in[4];
    const float* ab_w_in = args.in[5]; const float* ab_w_out = args.in[6]; const float* dlam = args.in[7]; const float* subln = args.in[8];
    const float* c_w_in = args.in[9]; const float* c_w_out = args.in[10]; const float* c_rel = args.in[11];
    const float* w_rg = args.in[12]; const float* b_rg = args.in[13]; const float* w_re = args.in[14]; const float* b_re = args.in[15];
    const float* w_gate = args.in[16]; const float* w_up = args.in[17]; const float* w_down = args.in[18];
    float* hbuf = args.out;
    bf16_t* WIN0 = (bf16_t*)(ws + WS_WIN0); bf16_t* WOUT0 = (bf16_t*)(ws + WS_WOUT0); bf16_t* WCIN = (bf16_t*)(ws + WS_WCIN); bf16_t* WCOUT = (bf16_t*)(ws + WS_WCOUT);
    bf16_t* WGU = (bf16_t*)(ws + WS_WGU); bf16_t* WD = (bf16_t*)(ws + WS_WD); bf16_t* RW = (bf16_t*)(ws + WS_RW);
    bf16_t* XN = (bf16_t*)(ws + WS_XN); bf16_t* BIG = (bf16_t*)(ws + WS_BIG); bf16_t* HB = (bf16_t*)(ws + WS_H); bf16_t* Y0 = (bf16_t*)(ws + WS_Y0); bf16_t* Y1 = (bf16_t*)(ws + WS_Y1);
    float* SSQ = (float*)(ws + WS_SSQ); int* LIST = (int*)(ws + WS_LIST); float* LW = (float*)(ws + WS_LIST + 4 * MiB);

    for (int u = tid; u < 256; u += NWAVES * 64) MISC[u] = 0u;
    __syncthreads();
    const int lo = args.ph_lo, hi = args.ph_hi;
    XcdBarrier bar; bar.bar = ctl + CW_BAR + args.li * XCD_BAR_WORDS; bar.x = 0; bar.st = nullptr;
    if (hi - lo > 1) bar = xcd_barrier_post(ctl + CW_BAR + args.li * XCD_BAR_WORDS, MISC);
#define IN(k) (lo <= (k) && (k) < hi)
#define SEAM(k) do { if (IN(k) && IN((k) + 1)) { unsigned long long ptb_ = 0; if (PROBE_T == 80) ptb_ = __builtin_amdgcn_s_memrealtime(); xcd_barrier(bar); if (PROBE_T == 80 && threadIdx.x == 0) MISC[240] += (unsigned)(__builtin_amdgcn_s_memrealtime() - ptb_); for (int xb_ = 0; xb_ < XBAR; ++xb_) xcd_barrier(bar); } } while (0)
    const int gw = vcu * NWAVES + wave, NGW = G * NWAVES;


#define MOE_TILES(l) do { __syncthreads(); if (tid < NEXP) MISC[64 + tid] = __hip_atomic_load(ctl + CW_CNT + (l) * 32 + tid, __ATOMIC_RELAXED, __HIP_MEMORY_SCOPE_AGENT); __syncthreads(); \
        if (tid == 0) { int a_ = 0; for (int e_ = 0; e_ < NEXP; ++e_) { MISC[16 + e_] = (unsigned)a_; a_ += ((int)MISC[64 + e_] + 255) >> 8; } MISC[16 + NEXP] = (unsigned)a_; } __syncthreads(); } while (0)
#define MOE_LAYER(l, P) \
    if (IN(P)) { router_phase(lds, MISC, hbuf, SSQ, ln_ffn + (l) * D, RW + (size_t)(l) * 2 * 48 * D, b_rg + (l) * 4, b_re + (l) * 32, XN, ctl + CW_CNT + (l) * 32, LIST, LW, vcu, G, wave, lane, tid); } \
    PT_ENDX(20 + (P)) SEAM(P); PT_BEGINX(21 + (P)) \
    if (IN((P) + 1)) { MOE_TILES(l); \
        pg8::MoeOrder<true> S{(const LAS int*)(lds + MISC_OFF + 64), (const LAS int*)(lds + MISC_OFF + 256), G, bx, 4, (int)MISC[16 + NEXP], 0u, (size_t)1024 * D * 2, (size_t)256 * D * 2, ((DUP & 16) && (l) == 0) ? 2 : 1}; \
        pg8::Gemm g{XN, WGU + (size_t)(l) * NEXP * 1024 * D, D, D, D, LIST}; pg8::EpiSwiglu E{HB}; \
        pg8::gemm_phase<pg8::EpiSwiglu, pg8::MoeOrder<true>>(lds + RING_OFF, g, S, E); } \
    PT_ENDX(21 + (P)) SEAM((P) + 1); PT_BEGINX(22 + (P)) \
    if (IN((P) + 2)) { MOE_TILES(l); \
        pg8::MoeOrder<false> S{(const LAS int*)(lds + MISC_OFF + 64), (const LAS int*)(lds + MISC_OFF + 256), G, bx, 4, (int)MISC[16 + NEXP], (unsigned)(256 * DEXP * 2), (size_t)D * DEXP * 2, (size_t)256 * DEXP * 2, ((DUP & 32) && (l) == 0) ? 2 : 1}; \
        pg8::Gemm g{HB, WD + (size_t)(l) * NEXP * D * DEXP, DEXP, DEXP, DEXP, nullptr}; pg8::EpiScatter E{Y0, Y1, LIST, LW}; \
        pg8::gemm_phase<pg8::EpiScatter, pg8::MoeOrder<false>>(lds + RING_OFF, g, S, E); } \
    PT_ENDX(22 + (P)) SEAM((P) + 2); PT_BEGINX(23 + (P))

    unsigned long long ptx_ = 0;
    PT_BEGINX(20)
    if (IN(0)) for (int rep = 0; rep < ((DUP & 1) ? 2 : 1); ++rep) {
        LAS float* scr = (LAS float*)(lds + RING_OFF + wave * 16384);
        constexpr int I1 = 16 * 80, I2 = 16 * 32, I3 = 16 * 96, I4 = 16 * 32, IE = 768, NITEMS = I1 + I2 + I3 + I4 + 64 * IE;
        PT_BEGIN(90)
        for (int it = gw; it < NITEMS; it += NGW) {
            int r = it;
            if (r < I1) { const int kb = r / 80, nb = r % 80, n0 = nb * 32; conv_item(ab_w_in, D, AB_IN, WIN0, kb * 64, n0, n0, (n0 < 512 || (n0 >= 1536 && n0 < 2048)) ? QSCALE : 1.f, scr, lane); continue; } r -= I1;
            if (r < I2) { const int kb = r / 32, nb = r % 32; conv_item(ab_w_out, D, D, WOUT0, kb * 64, nb * 32, nb * 32, 1.f, scr, lane); continue; } r -= I2;
            if (r < I3) { const int kb = r / 96, nb = r % 96, n0 = nb * 32; conv_item(c_w_in, D, C_IN, WCIN, kb * 64, n0, n0, n0 < 1024 ? QSCALE : 1.f, scr, lane); continue; } r -= I3;
            if (r < I4) { const int kb = r / 32, nb = r % 32; conv_item(c_w_out, D, D, WCOUT, kb * 64, nb * 32, nb * 32, 1.f, scr, lane); continue; } r -= I4;
            const int le = r / IE; r -= le * IE;
            if (r < 512) { const int up = r >> 8, q = r & 255, kb = q / 16, nb = q % 16, n0 = nb * 32;
                conv_item((up ? w_up : w_gate) + (size_t)le * D * DEXP, D, DEXP, WGU + (size_t)le * 1024 * D, kb * 64, n0, 256 * (n0 >> 7) + 128 * up + (n0 & 127), 1.f, scr, lane); }
            else { const int q = r - 512, kb = q / 32, nb = q % 32; conv_item(w_down + (size_t)le * DEXP * D, DEXP, D, WD + (size_t)le * D * DEXP, kb * 64, nb * 32, nb * 32, 1.f, scr, lane); }
        }
        PT_END(90)
        for (int i = (vcu * NWAVES * 64 + tid); i < 2 * 48 * D; i += G * NWAVES * 64) {
            const int l = i / (48 * D), e = (i / D) % 48, k = i % D;
            float v = 0.f; if (e < 4) v = w_rg[(size_t)l * D * 4 + k * 4 + e]; else if (e < 36) v = w_re[(size_t)l * D * 32 + k * 32 + (e - 4)];
            const unsigned hb = f2bf(v); const float lof = v - __uint_as_float(hb << 16);
            RW[((size_t)(l * 2 + 0) * 48 + e) * D + k] = (bf16_t)hb; RW[((size_t)(l * 2 + 1) * 48 + e) * D + k] = (bf16_t)f2bf(lof);
        }
        if (bx == 0 && wave == 0) { const float a = wave_sum(dlam[lane] * dlam[64 + lane]), b = wave_sum(dlam[128 + lane] * dlam[192 + lane]); if (lane == 0) ((float*)ctl)[CW_LAM] = __expf(a) - __expf(b) + 0.2f; }
        RowIO io{x, nullptr, nullptr, ln_mix, XN, nullptr};
        PT_BEGIN(92)
        for (int m = gw; m < NTOK; m += 2 * NGW) rms_row2<false, true, false, false>(io, m, m + NGW, lane);
        PT_END(92)
    }
    PT_ENDX(20)
    SEAM(0);
    PT_BEGINX(21)
    if (IN(1)) {
        pg8::Gemm g{XN, WIN0, D, D, D, nullptr}; pg8::DenseOrder S; S.init(NTOK, AB_INP, G, bx, D, D, (DUP & 2) ? 2 : 1);
        pg8::EpiBf16 E{BIG, AB_INP};
        pg8::gemm_phase<pg8::EpiBf16, pg8::DenseOrder>(lds + RING_OFF, g, S, E);
    }
    PT_ENDX(21)
    SEAM(1);
    PT_BEGINX(22)
    if (IN(2)) {
        const float lamv = __hip_atomic_load((float*)ctl + CW_LAM, __ATOMIC_RELAXED, __HIP_MEMORY_SCOPE_AGENT);
        for (int rep = 0; rep < ((DUP & 4) ? 2 : 1); ++rep) attn_a_phase(lds, BIG, t5, subln, lamv, XN, vcu, G, wave, lane, tid);
        if (!NAIVE_B) for (int rep = 0; rep < ((DUP & 8) ? 2 : 1); ++rep) attn_b_phase(lds, MISC, BIG, t5, XN, (unsigned*)hbuf + (size_t)bx * 131072, vcu, G, wave, lane, tid);
    }
    PT_ENDX(22)
    SEAM(2);
    PT_BEGINX(23)
    if (IN(3)) {
        pg8::Gemm g{XN, WOUT0, D, D, D, nullptr}; pg8::DenseOrder S; S.init(NTOK, D, G, bx, D, D, (DUP & 256) ? 2 : 1);
        pg8::EpiResid<false> E{x, hbuf, nullptr, nullptr, SSQ};
        pg8::gemm_phase<pg8::EpiResid<false>, pg8::DenseOrder, true>(lds + RING_OFF, g, S, E);
    }
    PT_ENDX(23)
    SEAM(3);
    PT_BEGINX(24)
    MOE_LAYER(0, 4)
    if (IN(7)) {
        RowIO io{hbuf, Y0, Y1, ln_mix + D, XN, hbuf};
        for (int m = gw; m < NTOK; m += 2 * NGW) rms_row2<true, true, true, false>(io, m, m + NGW, lane);
    }
    PT_ENDX(27)
    SEAM(7);
    PT_BEGINX(28)
    if (IN(8)) {
        pg8::Gemm g{XN, WCIN, D, D, D, nullptr}; pg8::DenseOrder S; S.init(NTOK, C_IN, G, bx, D, D, (DUP & 64) ? 2 : 1);
        pg8::EpiBf16 E{BIG, C_IN};
        pg8::gemm_phase<pg8::EpiBf16, pg8::DenseOrder>(lds + RING_OFF, g, S, E);
    }
    PT_ENDX(28)
    SEAM(8);
    PT_BEGINX(29)
    if (IN(9)) for (int rep = 0; rep < ((DUP & 128) ? 2 : 1); ++rep) attn_c_phase(lds, BIG, c_rel, XN, vcu, G, wave, lane, tid);
    PT_ENDX(29)
    SEAM(9);
    PT_BEGINX(30)
    if (IN(10)) {
        pg8::Gemm g{XN, WCOUT, D, D, D, nullptr}; pg8::DenseOrder S; S.init(NTOK, D, G, bx, D, D);
        pg8::EpiResid<false> E{hbuf, hbuf, nullptr, nullptr, SSQ};
        pg8::gemm_phase<pg8::EpiResid<false>, pg8::DenseOrder, true>(lds + RING_OFF, g, S, E);
    }
    PT_ENDX(30)
    SEAM(10);
    PT_BEGINX(31)
    MOE_LAYER(1, 11)
    if (IN(14)) {
        if (DUP & 512) { RowIO iod{hbuf, Y0, Y1, ln_final, nullptr, (float*)XN}; for (int m = gw; m < NTOK; m += 2 * NGW) rms_row2<true, false, false, true>(iod, m, m + NGW, lane); }
        RowIO io{hbuf, Y0, Y1, ln_final, nullptr, hbuf};
        for (int m = gw; m < NTOK; m += 2 * NGW) rms_row2<true, false, false, true>(io, m, m + NGW, lane);
    }
    PT_ENDX(34)
    if (PROBE_T) { __syncthreads(); const unsigned long long te = __builtin_amdgcn_s_memrealtime(); const unsigned long long w = 4ull * MISC[240]; while (__builtin_amdgcn_s_memrealtime() - te < w) __builtin_amdgcn_s_sleep(8); }
#undef IN
#undef SEAM
}

#ifndef OPT_MASK
#define OPT_MASK 0x7FFF
#endif
extern "C" void kernel_launch(void* const* d_in, const int* in_sizes, int n_in, void* d_out, int out_size, void* d_ws, size_t ws_size, hipStream_t stream) {
    static int grid = 0;
    if (grid == 0) {
        if (n_in != 19 || ws_size < WS_END) { fprintf(stderr, "kernel_launch: unexpected n_in %d or ws_size %zu (< %zu)\n", n_in, ws_size, (size_t)WS_END); grid = -1; return; }
        int dev = 0, cus = 0, per_cu = 0;
        if (hipGetDevice(&dev) != hipSuccess || hipDeviceGetAttribute(&cus, hipDeviceAttributeMultiprocessorCount, dev) != hipSuccess) { grid = -1; return; }
        if (hipFuncSetAttribute((const void*)mk_fwd, hipFuncAttributeMaxDynamicSharedMemorySize, LDS_BYTES) != hipSuccess) { fprintf(stderr, "kernel_launch: hipFuncSetAttribute failed\n"); grid = -1; return; }
        if (hipOccupancyMaxActiveBlocksPerMultiprocessor(&per_cu, (const void*)mk_fwd, NWAVES * 64, LDS_BYTES) != hipSuccess || per_cu < 1) fprintf(stderr, "kernel_launch: occupancy query says %d\n", per_cu);
        (void)hipGetLastError();
        grid = cus;
    }
    if (grid < 0) return;
    const float* x = (const float*)d_in[0]; const float* t5 = (const float*)d_in[1]; const float* ln_mix = (const float*)d_in[2]; const float* ln_ffn = (const float*)d_in[3];
    const float* ln_final = (const float*)d_in[4]; const float* ab_w_in = (const float*)d_in[5]; const float* ab_w_out = (const float*)d_in[6]; const float* dlam = (const float*)d_in[7];
    const float* subln = (const float*)d_in[8]; const float* c_w_in = (const float*)d_in[9]; const float* c_w_out = (const float*)d_in[10]; const float* c_rel = (const float*)d_in[11];
    const float* w_rg = (const float*)d_in[12]; const float* b_rg = (const float*)d_in[13]; const float* w_re = (const float*)d_in[14]; const float* b_re = (const float*)d_in[15];
    const float* w_gate = (const float*)d_in[16]; const float* w_up = (const float*)d_in[17]; const float* w_down = (const float*)d_in[18];
    float* hbuf = (float*)d_out; unsigned char* ws = (unsigned char*)d_ws;
    unsigned* ctl = (unsigned*)(ws + WS_CTL);
    bf16_t* XN = (bf16_t*)(ws + WS_XN); bf16_t* BIG = (bf16_t*)(ws + WS_BIG); bf16_t* HB = (bf16_t*)(ws + WS_H); bf16_t* Y0 = (bf16_t*)(ws + WS_Y0); bf16_t* Y1 = (bf16_t*)(ws + WS_Y1);
    float* SSQ = (float*)(ws + WS_SSQ); int* LIST = (int*)(ws + WS_LIST); float* LW = (float*)(ws + WS_LIST + 4 * MiB);
    (void)hipMemsetAsync(ws + WS_CTL, 0, CTL_ZERO_BYTES, stream);
    Args a{};
    for (int i = 0; i < 19; ++i) a.in[i] = (const float*)d_in[i];
    a.out = hbuf; a.ws = ws;
    int li = 0;
    for (int p = 0; p < NPHASE;) {
        if ((OPT_MASK >> p) & 1) {
            int q = p; while (q < NPHASE && ((OPT_MASK >> q) & 1)) { ++q; if (NAIVE_B && q == 3) break; }
            a.ph_lo = p; a.ph_hi = q; a.li = li++;
            hipLaunchKernelGGL(mk_fwd, dim3(grid), dim3(NWAVES * 64), LDS_BYTES, stream, a);
            p = q; continue;
        }
        ++p;
    }
}
```

```cpp
#include <hip/hip_runtime.h>
#include <cstdio>
#include <cstdint>

constexpr int D = 1024, BATCH = 8, SEQ = 4096, NTOK = BATCH * SEQ;
constexpr int AB_IN = 2500, AB_INP = 2560, C_IN = 3072;
constexpr int NEXP = 32, DEXP = 512;
constexpr float EPS = 1e-6f;
constexpr float LOG2E = 1.4426950408889634f;
constexpr float QSCALE = 0.125f * LOG2E;
constexpr size_t MiB = 1u << 20;

#define GAS __attribute__((address_space(1)))
#define LAS __attribute__((address_space(3)))
typedef unsigned short bf16_t;
typedef short bf16x8 __attribute__((ext_vector_type(8)));
typedef short s16x4 __attribute__((ext_vector_type(4)));
typedef float f32x2 __attribute__((ext_vector_type(2)));
typedef float f32x4 __attribute__((ext_vector_type(4)));
typedef float f32x16 __attribute__((ext_vector_type(16)));
typedef unsigned u32x2 __attribute__((ext_vector_type(2)));
typedef unsigned u32x4 __attribute__((ext_vector_type(4)));

constexpr size_t WS_CTL = 0, CTL_ZERO_BYTES = 256 * 1024;
constexpr size_t WS_RW = 1 * MiB;
constexpr size_t WS_SSQ = 2 * MiB;
constexpr size_t WS_LIST = 4 * MiB;
constexpr size_t WS_WIN0 = 12 * MiB;
constexpr size_t WS_WOUT0 = 17 * MiB;
constexpr size_t WS_WCIN = 19 * MiB;
constexpr size_t WS_WCOUT = 25 * MiB;
constexpr size_t WS_WGU = 28 * MiB;
constexpr size_t WS_WD = 156 * MiB;
constexpr size_t WS_XN = 220 * MiB;
constexpr size_t WS_BIG = 284 * MiB;
constexpr size_t WS_H = WS_BIG, WS_Y0 = WS_BIG + 72 * MiB, WS_Y1 = WS_Y0 + 64 * MiB;
constexpr size_t WS_END = WS_BIG + 200 * MiB;
static_assert(WS_Y1 + 64 * MiB <= WS_END, "ws map");

constexpr int NWAVES = 8;
constexpr int NPHASE = 15;
constexpr int RING_OFF = 0, RING_BYTES = 131072;
constexpr int TAB_OFF = RING_BYTES, TAB_BYTES = 27648;
constexpr int MISC_OFF = TAB_OFF + TAB_BYTES;
constexpr int LDS_BYTES = MISC_OFF + 1024;
static_assert(LDS_BYTES <= 160 * 1024, "LDS");


constexpr int CW_TMO = 0;
constexpr int CW_CNT = 64;
constexpr int CW_LAM = 192;
constexpr int CW_BAR = 4096;

__device__ __forceinline__ float wave_sum(float v) {
#pragma unroll
    for (int o = 1; o < 64; o <<= 1) v += __shfl_xor(v, o);
    return v;
}
__device__ __forceinline__ float wave_max(float v) {
#pragma unroll
    for (int o = 1; o < 64; o <<= 1) v = fmaxf(v, __shfl_xor(v, o));
    return v;
}
__host__ __device__ __forceinline__ int t5_bucket(int rel) {
    int n = rel < 0 ? -rel : rel;
    int b = n < 8 ? n : (8 + (n >= 15) + (n >= 27) + (n >= 50) + (n >= 91) + (n >= 166) + (n >= 305) + (n >= 559));
    return (rel > 0 ? 16 : 0) + b;
}
__device__ __forceinline__ unsigned cvt_pk_bf16(float lo, float hi) { unsigned r; asm volatile("v_cvt_pk_bf16_f32 %0, %1, %2" : "=v"(r) : "v"(lo), "v"(hi)); return r; }
__device__ __forceinline__ float bf2f(bf16_t b) { return __uint_as_float((unsigned)b << 16); }
__device__ __forceinline__ float bflo(unsigned w) { return __uint_as_float(w << 16); }
__device__ __forceinline__ float bfhi(unsigned w) { return __uint_as_float(w & 0xffff0000u); }
#ifndef PROBE_T
#define PROBE_T 0
#endif
#define PT_BEGIN(id) unsigned long long pt_t0_##id = 0; if (PROBE_T == (id)) { asm volatile("s_waitcnt vmcnt(0) lgkmcnt(0)" ::: "memory"); pt_t0_##id = __builtin_amdgcn_s_memrealtime(); }
#define PT_END(id) if (PROBE_T == (id)) { asm volatile("s_waitcnt vmcnt(0) lgkmcnt(0)" ::: "memory"); if (threadIdx.x == 0) ((volatile LAS unsigned*)(lds + MISC_OFF))[240] += (unsigned)(__builtin_amdgcn_s_memrealtime() - pt_t0_##id); }
#define PT_BEGINX(id) if (PROBE_T == (id)) { asm volatile("s_waitcnt vmcnt(0) lgkmcnt(0)" ::: "memory"); ptx_ = __builtin_amdgcn_s_memrealtime(); }
#define PT_ENDX(id) if (PROBE_T == (id)) { asm volatile("s_waitcnt vmcnt(0) lgkmcnt(0)" ::: "memory"); if (threadIdx.x == 0) ((volatile LAS unsigned*)(lds + MISC_OFF))[240] += (unsigned)(__builtin_amdgcn_s_memrealtime() - ptx_); }
#define LDS_WAIT() asm volatile("s_waitcnt lgkmcnt(0)" ::: "memory")
#define VM_WAIT() asm volatile("s_waitcnt vmcnt(0)" ::: "memory")
namespace pg8 {
constexpr int BM = 256, BK = 64, HALF = 128, HTB = HALF * BK * 2, STAGE_BYTES = 8 * HTB, NXCD = 8, WGM = 8;
__host__ __device__ __forceinline__ int lds_byte(int r, int c) { const int st = (r >> 4) * 2 + (c >> 5), rr = r & 15, cc = c & 31, ob = rr * 64 + cc * 2; return st * 1024 + (ob ^ (((ob >> 9) & 1) << 5)); }
__host__ __device__ __forceinline__ void stage_rc(int b, int& R, int& C) { const int st = b / 1024, sb = b % 1024, swz = sb ^ (((sb >> 9) & 1) << 5); R = (st >> 1) * 16 + swz / 64; C = (st & 1) * 32 + (swz % 64) / 2; }
__host__ __device__ __forceinline__ int perm32(int rho) { const int n = rho >> 4, i = rho & 15; return 8 * (i >> 2) + 4 * n + (i & 3); }

struct Unit { int pm, pn, e, rows, lbase; unsigned aoff; size_t boff; };
struct Gemm { const bf16_t* A; const bf16_t* Bt; int lda, ldb, K; const int* list; };

struct DenseOrder {
    static constexpr bool GATHER = false;
    int nM, nN, nwg, G, c, rep; unsigned astep; size_t bstep;
    __device__ void init(int M, int N, int G_, int c_, int lda, int ldb, int rep_ = 1) { nM = M / BM; nN = N / BM; nwg = nM * nN; G = G_; c = c_; rep = rep_; astep = (unsigned)BM * lda * 2u; bstep = (size_t)BM * ldb * 2; }
    __device__ bool next(int i, Unit& u) const {
        long L = (long)i * G + c; if (L >= (long)nwg * rep) return false;
        if (L >= nwg) L -= nwg;
        int wgid = (int)L; { const int q = nwg / NXCD, r = nwg % NXCD, xcd = wgid % NXCD, off = wgid / NXCD; wgid = (xcd < r ? xcd * (q + 1) : r * (q + 1) + (xcd - r) * q) + off; }
        const int nig = WGM * nN, gid = wgid / nig, fm = gid * WGM, gsz = (nM - fm) < WGM ? (nM - fm) : WGM;
        u.pm = fm + ((wgid % nig) % gsz); u.pn = (wgid % nig) / gsz; u.e = 0; u.rows = BM; u.lbase = 0; u.aoff = (unsigned)u.pm * astep; u.boff = (size_t)u.pn * bstep; return true;
    }
};
template <bool GATH> struct MoeOrder {
    static constexpr bool GATHER = GATH;
    const LAS int* tb; const LAS int* cnt; int G, c, npn, NT; unsigned atile; size_t bexp, bpn; int rep;
    __device__ bool next(int i, Unit& u) const {
        int L = i * G + c; if (L >= NT * npn * rep) return false;
        if (L >= NT * npn) L -= NT * npn;
        const int T = L / npn; u.pn = L - T * npn; u.pm = T;
        int e = 0;
#pragma unroll 1
        for (int j = 1; j < NEXP; ++j) e = (tb[j] <= T) ? j : e;
        e = __builtin_amdgcn_readfirstlane(e);
        const int lt = T - tb[e]; const int r = cnt[e] - 256 * lt;
        u.e = e; u.rows = r < 256 ? r : 256; u.lbase = e * NTOK + 256 * lt; u.aoff = (unsigned)T * atile; u.boff = (size_t)e * bexp + (size_t)u.pn * bpn; return true;
    }
};

struct EpiBf16 {
    static constexpr int PID = 71;
    bf16_t* O; int ldc;
    __device__ __forceinline__ void operator()(const f32x4 (&acc)[2][2][4][2], const Unit& u, int wr, int wc, int fr, int fq) const {
        const int row0 = u.pm * BM + wr * 64 + fr, col0 = u.pn * BM + wc * 32 + 8 * fq;
#pragma unroll
        for (int ai = 0; ai < 2; ++ai)
#pragma unroll
            for (int m = 0; m < 4; ++m) { bf16_t* rowp = O + (size_t)(row0 + ai * HALF + m * 16) * ldc + col0;
#pragma unroll
                for (int bj = 0; bj < 2; ++bj) { const f32x4 v0 = acc[ai][bj][m][0], v1 = acc[ai][bj][m][1];
                    u32x4 w; w.x = cvt_pk_bf16(v0[0], v0[1]); w.y = cvt_pk_bf16(v0[2], v0[3]); w.z = cvt_pk_bf16(v1[0], v1[1]); w.w = cvt_pk_bf16(v1[2], v1[3]);
                    *(u32x4*)(rowp + bj * HALF) = w; } }
    }
};
template <bool ADDY> struct EpiResid {
    static constexpr int PID = 72;
    const float* R; float* out; const bf16_t* Y0; const bf16_t* Y1; float* ssq;
    __device__ __forceinline__ void operator()(const f32x4 (&acc)[2][2][4][2], const Unit& u, int wr, int wc, int fr, int fq) const {
        const int row0 = u.pm * BM + wr * 64 + fr, col0 = u.pn * BM + wc * 32 + 8 * fq;
#pragma unroll
        for (int ai = 0; ai < 2; ++ai) {
            f32x4 rv[4][2][2];
#pragma unroll
            for (int m = 0; m < 4; ++m) { const size_t off = (size_t)(row0 + ai * HALF + m * 16) * D + col0;
#pragma unroll
                for (int bj = 0; bj < 2; ++bj) { rv[m][bj][0] = *(const f32x4*)(R + off + bj * HALF); rv[m][bj][1] = *(const f32x4*)(R + off + bj * HALF + 4); } }
#pragma unroll
            for (int m = 0; m < 4; ++m) { const int row = row0 + ai * HALF + m * 16; const size_t off = (size_t)row * D + col0; float ss = 0.f;
#pragma unroll
                for (int bj = 0; bj < 2; ++bj) {
                    f32x4 v0 = acc[ai][bj][m][0] + rv[m][bj][0], v1 = acc[ai][bj][m][1] + rv[m][bj][1];
                    if (ADDY) { const u32x4 a = *(const u32x4*)(Y0 + off + bj * HALF), b = *(const u32x4*)(Y1 + off + bj * HALF);
                        v0[0] += bflo(a.x) + bflo(b.x); v0[1] += bfhi(a.x) + bfhi(b.x); v0[2] += bflo(a.y) + bflo(b.y); v0[3] += bfhi(a.y) + bfhi(b.y);
                        v1[0] += bflo(a.z) + bflo(b.z); v1[1] += bfhi(a.z) + bfhi(b.z); v1[2] += bflo(a.w) + bflo(b.w); v1[3] += bfhi(a.w) + bfhi(b.w); }
                    *(f32x4*)(out + off + bj * HALF) = v0; *(f32x4*)(out + off + bj * HALF + 4) = v1;
                    ss += v0[0] * v0[0] + v0[1] * v0[1] + v0[2] * v0[2] + v0[3] * v0[3] + v1[0] * v1[0] + v1[1] * v1[1] + v1[2] * v1[2] + v1[3] * v1[3]; }
                ss += __shfl_xor(ss, 16); ss += __shfl_xor(ss, 32);
                if (fq == 0) ssq[(size_t)row * 16 + u.pn * 4 + wc] = ss; }
        }
    }
};
struct EpiSwiglu {
    static constexpr int PID = 73;
    bf16_t* H;
    __device__ __forceinline__ void operator()(const f32x4 (&acc)[2][2][4][2], const Unit& u, int wr, int wc, int fr, int fq) const {
        const int row0 = u.pm * BM + wr * 64 + fr, col0 = u.pn * HALF + wc * 32 + 8 * fq;
#pragma unroll
        for (int ai = 0; ai < 2; ++ai)
#pragma unroll
            for (int m = 0; m < 4; ++m) { float o[8];
#pragma unroll
                for (int n = 0; n < 2; ++n)
#pragma unroll
                    for (int j = 0; j < 4; ++j) { const float g = acc[ai][0][m][n][j], up = acc[ai][1][m][n][j];
                        o[n * 4 + j] = g * __builtin_amdgcn_rcpf(1.f + __builtin_amdgcn_exp2f(-g * LOG2E)) * up; }
                u32x4 w; w.x = cvt_pk_bf16(o[0], o[1]); w.y = cvt_pk_bf16(o[2], o[3]); w.z = cvt_pk_bf16(o[4], o[5]); w.w = cvt_pk_bf16(o[6], o[7]);
                *(u32x4*)(H + (size_t)(row0 + ai * HALF + m * 16) * DEXP + col0) = w; }
    }
};
struct EpiScatter {
    static constexpr int PID = 74;
    bf16_t* Y0; bf16_t* Y1; const int* list; const float* lw;
    __device__ __forceinline__ void operator()(const f32x4 (&acc)[2][2][4][2], const Unit& u, int wr, int wc, int fr, int fq) const {
        const int col0 = u.pn * BM + wc * 32 + 8 * fq;
        int ent[8]; float wgt[8];
#pragma unroll
        for (int k = 0; k < 8; ++k) { const int r = (k >> 2) * HALF + wr * 64 + (k & 3) * 16 + fr; const bool ok = r < u.rows; ent[k] = ok ? list[u.lbase + r] : -1; wgt[k] = ok ? lw[u.lbase + r] : 0.f; }
        const size_t ystride = (size_t)(Y1 - Y0);
#pragma unroll
        for (int ai = 0; ai < 2; ++ai)
#pragma unroll
            for (int m = 0; m < 4; ++m) { const int e = ent[ai * 4 + m]; const float w = wgt[ai * 4 + m];
                if (e >= 0) { bf16_t* rowp = Y0 + (size_t)(e & 1) * ystride + (size_t)(e >> 1) * D + col0;
#pragma unroll
                    for (int bj = 0; bj < 2; ++bj) { const f32x4 v0 = acc[ai][bj][m][0] * w, v1 = acc[ai][bj][m][1] * w;
                        u32x4 o; o.x = cvt_pk_bf16(v0[0], v0[1]); o.y = cvt_pk_bf16(v0[2], v0[3]); o.z = cvt_pk_bf16(v1[0], v1[1]); o.w = cvt_pk_bf16(v1[2], v1[3]);
                        *(u32x4*)(rowp + bj * HALF) = o; } } }
    }
};

template <class Epi, class Sched, bool ALIGN_EPI = true>
__device__ __forceinline__ void gemm_phase(LAS unsigned char* lds, const Gemm g, const Sched& S, const Epi& E) {
    const int tid = threadIdx.x, wid = __builtin_amdgcn_readfirstlane(tid >> 6), lane = tid & 63, wr = wid >> 2, wc = wid & 3, fr = lane & 15, fq = lane >> 4;
    const int K = g.K, nt = K / BK;
    int R0, C0; stage_rc(tid * 16, R0, C0);
    unsigned voffB[2];
#pragma unroll
    for (int i = 0; i < 2; ++i) { const int R = R0 + 64 * i; const int Rb = (R & ~31) + perm32(R & 31); voffB[i] = (unsigned)(Rb * g.ldb + C0) * 2u; }
    const unsigned rowb = (unsigned)g.lda * 2u, colb = (unsigned)C0 * 2u;
    const unsigned kstep = (unsigned)(BK * 2);
    const size_t hstepB = (size_t)HALF * g.ldb * 2;
    const unsigned ldsw = (unsigned)wid * 1024u;
    const int aoff = lds_byte(wr * 64 + fr, fq * 8), boff = lds_byte(wc * 32 + fr, fq * 8);
    const char* Ab = (const char*)g.A;
#define PG8_SA(b, h) (((b) * 2 + (h)) * HTB)
#define PG8_SB(b, h) ((4 + (b) * 2 + (h)) * HTB)
#define PG8_STAGEB(bufoff, gbase) do { _Pragma("unroll") for (int _i = 0; _i < 2; ++_i) \
        __builtin_amdgcn_global_load_lds((const unsigned*)((const char*)(gbase) + voffB[_i]), (LAS unsigned*)(lds + (bufoff) + ldsw + _i * 8192), 16, 0, 0); } while (0)
#define PG8_STAGEA(bufoff, arr, h, kb) do { _Pragma("unroll") for (int _i = 0; _i < 2; ++_i) \
        __builtin_amdgcn_global_load_lds((const unsigned*)(Ab + (size_t)((arr)[2 * (h) + _i] + (kb))), (LAS unsigned*)(lds + (bufoff) + ldsw + _i * 8192), 16, 0, 0); } while (0)
#define PG8_LDA(dst, b, h) do { _Pragma("unroll") for (int m = 0; m < 4; ++m) _Pragma("unroll") for (int k = 0; k < 2; ++k) dst[m][k] = *(const LAS bf16x8*)(lds + PG8_SA(b, h) + aoff + m * 2048 + k * 1024); } while (0)
#define PG8_LDB(dst, b, h) do { _Pragma("unroll") for (int n = 0; n < 2; ++n) _Pragma("unroll") for (int k = 0; k < 2; ++k) dst[n][k] = *(const LAS bf16x8*)(lds + PG8_SB(b, h) + boff + n * 2048 + k * 1024); } while (0)
#define PG8_MMA(ai, bj, At, Bt) do { __builtin_amdgcn_s_setprio(1); _Pragma("unroll") for (int m = 0; m < 4; ++m) _Pragma("unroll") for (int n = 0; n < 2; ++n) _Pragma("unroll") for (int k = 0; k < 2; ++k) \
        acc[ai][bj][m][n] = __builtin_amdgcn_mfma_f32_16x16x32_bf16(Bt[n][k], At[m][k], acc[ai][bj][m][n], 0, 0, 0); __builtin_amdgcn_s_setprio(0); } while (0)
#define PG8_WAIT_V(n) asm volatile("s_waitcnt vmcnt(" #n ")" ::: "memory")
#define PG8_WAIT_L(n) asm volatile("s_waitcnt lgkmcnt(" #n ")" ::: "memory")
#define PG8_BAR __builtin_amdgcn_s_barrier()
#define PG8_SCHED __builtin_amdgcn_sched_barrier(0)
#define PG8_ROWS(arr, u) do { _Pragma("unroll") for (int _j = 0; _j < 4; ++_j) { \
        if constexpr (Sched::GATHER) { const int _r = R0 + 64 * _j; const int _ent = (_r < (u).rows) ? g.list[(u).lbase + _r] : 0; (arr)[_j] = (unsigned)(_ent >> 1) * rowb + colb; } \
        else (arr)[_j] = (u).aoff + (unsigned)(R0 + 64 * _j) * rowb + colb; } } while (0)
    Unit cur, nxt; int ui = 0;
    if (!S.next(0, cur)) return;
    f32x4 acc[2][2][4][2];
#pragma unroll
    for (int a = 0; a < 2; ++a)
#pragma unroll
        for (int b = 0; b < 2; ++b)
#pragma unroll
            for (int m = 0; m < 4; ++m)
#pragma unroll
                for (int n = 0; n < 2; ++n) acc[a][b][m][n] = (f32x4){0.f, 0.f, 0.f, 0.f};
    bf16x8 At[4][2], B0[2][2], B1[2][2];
    unsigned ca[4], na[4];
    PG8_ROWS(ca, cur);
    const char* cB = (const char*)g.Bt + cur.boff;
    PG8_STAGEB(PG8_SB(0, 0), cB); PG8_STAGEB(PG8_SB(0, 1), cB + hstepB); PG8_STAGEA(PG8_SA(0, 0), ca, 0, 0u); PG8_STAGEA(PG8_SA(0, 1), ca, 1, 0u);
    if (wr == 1) PG8_BAR;
    PG8_WAIT_V(2); PG8_BAR;
    PG8_STAGEB(PG8_SB(1, 0), cB + kstep); PG8_STAGEA(PG8_SA(1, 0), ca, 0, kstep); PG8_STAGEB(PG8_SB(1, 1), cB + hstepB + kstep);
    PG8_WAIT_V(6); PG8_BAR;
    for (;;) {
        const bool has_next = S.next(ui + 1, nxt);
        if (has_next) { PG8_ROWS(na, nxt); } else {
#pragma unroll
            for (int j = 0; j < 4; ++j) na[j] = ca[j]; }
        const char* nB = has_next ? (const char*)g.Bt + nxt.boff : cB;
        for (int t = 0; t < nt; t += 2) {
            const bool last = (t == nt - 2);
            const unsigned k1 = (unsigned)(t + 1) * kstep;
            const unsigned k2 = last ? 0u : (unsigned)(t + 2) * kstep, k3 = k2 + kstep;
            unsigned a2[4];
#pragma unroll
            for (int j = 0; j < 4; ++j) a2[j] = last ? na[j] : ca[j];
            const char* b2 = (last ? nB : cB) + k2; const char* b3 = b2 + kstep;
            PG8_LDB(B0, 0, 0); PG8_LDB(B1, 0, 1); PG8_SCHED; PG8_LDA(At, 0, 0); PG8_STAGEA(PG8_SA(1, 1), ca, 1, k1);
            PG8_WAIT_V(8); PG8_WAIT_L(0); PG8_BAR; PG8_MMA(0, 0, At, B0); PG8_MMA(0, 1, At, B1); PG8_BAR; PG8_SCHED;
            PG8_LDA(At, 0, 1); PG8_STAGEB(PG8_SB(0, 0), b2); PG8_STAGEB(PG8_SB(0, 1), b2 + hstepB); PG8_STAGEA(PG8_SA(0, 0), a2, 0, k2);
            PG8_WAIT_V(8); PG8_WAIT_L(0); PG8_BAR; PG8_MMA(1, 0, At, B0); PG8_MMA(1, 1, At, B1); PG8_BAR; PG8_SCHED;
            PG8_LDB(B0, 1, 0); PG8_LDB(B1, 1, 1); PG8_SCHED; PG8_LDA(At, 1, 0); PG8_STAGEA(PG8_SA(0, 1), a2, 1, k2);
            PG8_WAIT_V(8); PG8_WAIT_L(0); PG8_BAR; PG8_MMA(0, 0, At, B0); PG8_MMA(0, 1, At, B1); PG8_BAR; PG8_SCHED;
            PG8_LDA(At, 1, 1); PG8_STAGEB(PG8_SB(1, 0), b3); PG8_STAGEB(PG8_SB(1, 1), b3 + hstepB); PG8_STAGEA(PG8_SA(1, 0), a2, 0, k3);
            PG8_WAIT_V(8); PG8_WAIT_L(0); PG8_BAR; PG8_MMA(1, 0, At, B0); PG8_MMA(1, 1, At, B1); PG8_BAR; PG8_SCHED;
        }
        if constexpr (ALIGN_EPI) { if (wr == 0) PG8_BAR; }
        { unsigned long long pte_ = 0; if (PROBE_T == 70 || PROBE_T == Epi::PID) { asm volatile("s_waitcnt vmcnt(0) lgkmcnt(0)" ::: "memory"); pte_ = __builtin_amdgcn_s_memrealtime(); }
          E(acc, cur, wr, wc, fr, fq);
          if (PROBE_T == 70 || PROBE_T == Epi::PID) { asm volatile("s_waitcnt vmcnt(0) lgkmcnt(0)" ::: "memory"); if (threadIdx.x == 0) ((volatile LAS unsigned*)(lds + MISC_OFF))[240] += (unsigned)(__builtin_amdgcn_s_memrealtime() - pte_); } }
        if (!has_next) break;
#pragma unroll
        for (int a = 0; a < 2; ++a)
#pragma unroll
            for (int b = 0; b < 2; ++b)
#pragma unroll
                for (int m = 0; m < 4; ++m)
#pragma unroll
                    for (int n = 0; n < 2; ++n) acc[a][b][m][n] = (f32x4){0.f, 0.f, 0.f, 0.f};
        cur = nxt; cB = nB; ++ui;
#pragma unroll
        for (int j = 0; j < 4; ++j) ca[j] = na[j];
        if constexpr (ALIGN_EPI) { if (wr == 1) PG8_BAR; }
    }
    PG8_WAIT_V(0);
    if constexpr (!ALIGN_EPI) { if (wr == 0) PG8_BAR; }
    PG8_BAR;
#undef PG8_SA
#undef PG8_SB
#undef PG8_STAGEA
#undef PG8_STAGEB
#undef PG8_LDA
#undef PG8_LDB
#undef PG8_MMA
#undef PG8_WAIT_V
#undef PG8_WAIT_L
#undef PG8_BAR
#undef PG8_SCHED
#undef PG8_ROWS
}
}
#define XB_TMO      128
#define XB_XCNT(j)  (256  + 64 * (j))
#define XB_XSUB(j)  (1280 + 64 * (j))
#define XB_XGEN(j)  (2304 + 64 * (j))
#define XB_TOP      3328
#define XB_TOPGEN   3392
#define XCD_BAR_WORDS 3456
#define XB_SPIN_CAP (1u << 18)

__device__ __forceinline__ unsigned xb_ld(unsigned* p)              { return __hip_atomic_load(p, __ATOMIC_RELAXED, __HIP_MEMORY_SCOPE_AGENT); }
__device__ __forceinline__ unsigned xb_add(unsigned* p, unsigned v) { return __hip_atomic_fetch_add(p, v, __ATOMIC_RELAXED, __HIP_MEMORY_SCOPE_AGENT); }
__device__ __forceinline__ unsigned xb_xcc_id() { return (unsigned)__builtin_amdgcn_s_getreg((3 << 11) | 20) & 0xFu; }
#define XB_SPIN(cond, bar) do { unsigned _sp = 0; while (cond) { __builtin_amdgcn_s_sleep(1); \
    if ((++_sp & 255u) == 0u) { if (xb_ld(&(bar)[XB_TMO])) break; if (_sp > XB_SPIN_CAP) { atomicAdd(&(bar)[XB_TMO], 1u); break; } } } } while (0)

struct XcdBarrier {
    unsigned* bar; unsigned x;
    volatile LAS unsigned* st;
};

__device__ __forceinline__ XcdBarrier xcd_barrier_post(unsigned* bar, volatile LAS unsigned* st) {
    XcdBarrier b; b.bar = bar; b.x = xb_xcc_id(); b.st = st;
    if (threadIdx.x == 0) (void)xb_add(&bar[XB_XCNT(b.x)], 1u);
    return b;
}
__device__ __forceinline__ void xcd_barrier_complete(unsigned* bar, unsigned x, unsigned& nloc, unsigned& nx) {
    const unsigned G = gridDim.x * gridDim.y * gridDim.z;
    unsigned sum, cnt, mine, sp = 0u;
    for (;;) {
        sum = 0u; cnt = 0u; mine = 0u;
#pragma unroll
        for (unsigned j = 0; j < 16; ++j) { const unsigned c = xb_ld(&bar[XB_XCNT(j)]); sum += c; cnt += (c > 0u) ? 1u : 0u; mine = (j == x) ? c : mine; }
        if (sum == G) break;
        __builtin_amdgcn_s_sleep(1);
        if ((++sp & 255u) == 0u) { if (xb_ld(&bar[XB_TMO])) break; if (sp > XB_SPIN_CAP) { atomicAdd(&bar[XB_TMO], 1u); break; } }
    }
    nloc = mine > 0u ? mine : 1u; nx = cnt > 0u ? cnt : 1u;
}

__device__ __forceinline__ void xcd_barrier(const XcdBarrier& b) {
    asm volatile("s_waitcnt vmcnt(0)" ::: "memory");
    __syncthreads();
    if (threadIdx.x == 0) {
        unsigned* bar = b.bar;
        __builtin_amdgcn_s_waitcnt(0);
        unsigned nloc = b.st[0], nx = b.st[1];
        if (nloc == 0u) { xcd_barrier_complete(bar, b.x, nloc, nx); b.st[0] = nloc; b.st[1] = nx; }
        const unsigned old = xb_add(&bar[XB_XSUB(b.x)], 1u);
        const unsigned gen = old / nloc;
        if (old + 1u == (gen + 1u) * nloc) {
            __builtin_amdgcn_fence(__ATOMIC_RELEASE, "agent");
            asm volatile("s_waitcnt vmcnt(0)" ::: "memory");
            const unsigned og = xb_add(&bar[XB_TOP], 1u);
            const unsigned tg = og / nx;
            if (og + 1u == (tg + 1u) * nx) xb_add(&bar[XB_TOPGEN], 1u);
            else XB_SPIN(xb_ld(&bar[XB_TOPGEN]) == tg, bar);
            __builtin_amdgcn_fence(__ATOMIC_ACQUIRE, "agent");
            xb_add(&bar[XB_XGEN(b.x)], 1u);
            asm volatile("s_waitcnt vmcnt(0)" ::: "memory");
        } else {
            XB_SPIN(xb_ld(&bar[XB_XGEN(b.x)]) == gen, bar);
            __builtin_amdgcn_fence(__ATOMIC_ACQUIRE, "agent");
            asm volatile("s_waitcnt vmcnt(0)" ::: "memory");
        }
    }
    __syncthreads();
}
__device__ __forceinline__ unsigned f2bf(float f) { unsigned u = __builtin_bit_cast(unsigned, f); return (u + 0x7fffu + ((u >> 16) & 1u)) >> 16; }
__device__ __forceinline__ unsigned pk2(float lo, float hi) { return f2bf(lo) | (f2bf(hi) << 16); }

__device__ __forceinline__ void conv_item(const float* W, int K, int N, bf16_t* WT, int k0, int n0, int dst_row0, float scale, LAS float* scr, int lane) {
    const int nn = n0 + (lane & 31); const bool ok = nn < N;
    float wv[32];
#pragma unroll
    for (int i = 0; i < 32; ++i) { const int kk = 2 * i + (lane >> 5); wv[i] = ok ? W[(size_t)(k0 + kk) * N + nn] : 0.f; }
#pragma unroll
    for (int i = 0; i < 32; ++i) { const int kk = 2 * i + (lane >> 5); scr[kk * 33 + (lane & 31)] = wv[i] * scale; }
    LDS_WAIT(); asm volatile("" ::: "memory");
    const int c = lane & 7;
#pragma unroll
    for (int j = 0; j < 4; ++j) { const int n = (lane >> 3) + 8 * j; const LAS float* s = scr + (8 * c) * 33 + n;
        u32x4 o; o.x = pk2(s[0 * 33], s[1 * 33]); o.y = pk2(s[2 * 33], s[3 * 33]); o.z = pk2(s[4 * 33], s[5 * 33]); o.w = pk2(s[6 * 33], s[7 * 33]);
        *(GAS u32x4*)(WT + (size_t)(dst_row0 + n) * K + k0 + 8 * c) = o; }
    LDS_WAIT(); asm volatile("" ::: "memory");
}

struct RowIO { const float* src; const bf16_t* y0; const bf16_t* y1; const float* gain; bf16_t* xn; float* fout; };
template <bool ADDY, bool WXN, bool WSUM, bool WNORM>
__device__ __forceinline__ void rms_row(const RowIO& io, int row, int lane) {
    const GAS f32x4* xr = (const GAS f32x4*)(io.src + (size_t)row * D) + lane;
    f32x4 v[4]; float s = 0.f;
#pragma unroll
    for (int j = 0; j < 4; ++j) v[j] = xr[64 * j];
    if (ADDY) {
        const GAS u32x2* a = (const GAS u32x2*)(io.y0 + (size_t)row * D) + lane; const GAS u32x2* b = (const GAS u32x2*)(io.y1 + (size_t)row * D) + lane;
#pragma unroll
        for (int j = 0; j < 4; ++j) { const u32x2 ya = a[64 * j], yb = b[64 * j];
            v[j][0] += bflo(ya.x) + bflo(yb.x); v[j][1] += bfhi(ya.x) + bfhi(yb.x); v[j][2] += bflo(ya.y) + bflo(yb.y); v[j][3] += bfhi(ya.y) + bfhi(yb.y); }
    }
#pragma unroll
    for (int j = 0; j < 4; ++j) s += (v[j][0] * v[j][0] + v[j][1] * v[j][1]) + (v[j][2] * v[j][2] + v[j][3] * v[j][3]);
    const float r = __builtin_amdgcn_rsqf(wave_sum(s) * (1.f / D) + EPS);
    const GAS f32x4* gg = (const GAS f32x4*)io.gain + lane;
#pragma unroll
    for (int j = 0; j < 4; ++j) { const f32x4 o = v[j] * r * gg[64 * j];
        if (WSUM) ((GAS f32x4*)(io.fout + (size_t)row * D) + lane)[64 * j] = v[j];
        if (WXN) { u32x2 w; w.x = cvt_pk_bf16(o[0], o[1]); w.y = cvt_pk_bf16(o[2], o[3]); ((GAS u32x2*)(io.xn + (size_t)row * D) + lane)[64 * j] = w; }
        if (WNORM) ((GAS f32x4*)(io.fout + (size_t)row * D) + lane)[64 * j] = o; }
}

template <bool ADDY, bool WXN, bool WSUM, bool WNORM>
__device__ __forceinline__ void rms_row2(const RowIO& io, int row0, int row1, int lane) {
    f32x4 v[2][4]; u32x2 ya[2][4], yb[2][4];
#pragma unroll
    for (int k = 0; k < 2; ++k) { const int row = k ? row1 : row0; const GAS f32x4* xr = (const GAS f32x4*)(io.src + (size_t)row * D) + lane;
#pragma unroll
        for (int j = 0; j < 4; ++j) v[k][j] = xr[64 * j];
        if (ADDY) { const GAS u32x2* a = (const GAS u32x2*)(io.y0 + (size_t)row * D) + lane; const GAS u32x2* b = (const GAS u32x2*)(io.y1 + (size_t)row * D) + lane;
#pragma unroll
            for (int j = 0; j < 4; ++j) { ya[k][j] = a[64 * j]; yb[k][j] = b[64 * j]; } } }
    f32x4 gg[4];
    { const GAS f32x4* gp = (const GAS f32x4*)io.gain + lane;
#pragma unroll
      for (int j = 0; j < 4; ++j) gg[j] = gp[64 * j]; }
#pragma unroll
    for (int k = 0; k < 2; ++k) { const int row = k ? row1 : row0; float s = 0.f;
        if (ADDY) {
#pragma unroll
            for (int j = 0; j < 4; ++j) { v[k][j][0] += bflo(ya[k][j].x) + bflo(yb[k][j].x); v[k][j][1] += bfhi(ya[k][j].x) + bfhi(yb[k][j].x); v[k][j][2] += bflo(ya[k][j].y) + bflo(yb[k][j].y); v[k][j][3] += bfhi(ya[k][j].y) + bfhi(yb[k][j].y); } }
#pragma unroll
        for (int j = 0; j < 4; ++j) s += (v[k][j][0] * v[k][j][0] + v[k][j][1] * v[k][j][1]) + (v[k][j][2] * v[k][j][2] + v[k][j][3] * v[k][j][3]);
        const float r = __builtin_amdgcn_rsqf(wave_sum(s) * (1.f / D) + EPS);
#pragma unroll
        for (int j = 0; j < 4; ++j) { const f32x4 o = v[k][j] * r * gg[j];
            if (WSUM) ((GAS f32x4*)(io.fout + (size_t)row * D) + lane)[64 * j] = v[k][j];
            if (WXN) { u32x2 w; w.x = cvt_pk_bf16(o[0], o[1]); w.y = cvt_pk_bf16(o[2], o[3]); ((GAS u32x2*)(io.xn + (size_t)row * D) + lane)[64 * j] = w; }
            if (WNORM) ((GAS f32x4*)(io.fout + (size_t)row * D) + lane)[64 * j] = o; } }
}
__device__ __forceinline__ void router_phase(LAS unsigned char* lds, volatile LAS unsigned* MISC, const float* hbuf, const float* SSQ, const float* gain, const bf16_t* RWl, const float* brg, const float* bre,
                                             bf16_t* XN, unsigned* gcnt, int* LIST, float* LW, int vcu, int G, int wave, int lane, int tid) {
    constexpr int WLO_OFF = 73728, GAIN_OFF = 147456;
    LAS float* lg = (LAS float*)(lds + RING_OFF) + wave * (16 * 48);
    volatile LAS unsigned* lcnt = MISC + 64;
    volatile LAS unsigned* lbase = MISC + 96;
    const int tr = lane & 15, g = lane >> 4;
    constexpr int NTILE = NTOK / 16;
    const int rounds = (NTILE + G * NWAVES - 1) / (G * NWAVES);
    LAS float* glds = (LAS float*)(lds + GAIN_OFF);
    __syncthreads(); if (tid < 2 * NEXP) MISC[64 + tid] = 0u; for (int i = tid; i < D / 4; i += NWAVES * 64) ((LAS f32x4*)glds)[i] = ((const GAS f32x4*)gain)[i]; __syncthreads();
    for (int r = 0; r < rounds; ++r) {
        for (int pid = tid; pid < 9216; pid += NWAVES * 64) { const int hl = pid / 4608, rem = pid % 4608, e = rem >> 7, p = rem & 127;
            *(LAS u32x4*)(lds + hl * WLO_OFF + e * 2048 + ((p ^ (e & 15)) << 4)) = *(const GAS u32x4*)(RWl + ((size_t)(hl * 48 + e) * D + p * 8)); }
        __syncthreads();
        const int tile = (r * G + vcu) * NWAVES + wave;
        const bool act = tile < NTILE;
        int e1 = 0, e2 = 0, p1 = 0, p2 = 0; float w1 = 0.f, w2 = 0.f; int tok = 0;
        f32x4 acc[3] = {(f32x4){0.f, 0.f, 0.f, 0.f}, (f32x4){0.f, 0.f, 0.f, 0.f}, (f32x4){0.f, 0.f, 0.f, 0.f}};
        if (act) {
            const int t0 = tile * 16; tok = t0 + tr;
            const GAS f32x4* sq = (const GAS f32x4*)(SSQ + (size_t)tok * 16);
            const f32x4 s0 = sq[0], s1 = sq[1], s2 = sq[2], s3 = sq[3];
            const float ss = ((s0[0] + s0[1]) + (s0[2] + s0[3])) + ((s1[0] + s1[1]) + (s1[2] + s1[3])) + ((s2[0] + s2[1]) + (s2[2] + s2[3])) + ((s3[0] + s3[1]) + (s3[2] + s3[3]));
            const float rstd = __builtin_amdgcn_rsqf(ss * (1.f / D) + EPS);
            const float* hrow = hbuf + (size_t)tok * D + 8 * g;
            const LAS float* gl = glds + 8 * g;
            bf16_t* xrow = XN + (size_t)tok * D + 8 * g;
            PT_BEGIN(40)
#pragma unroll 1
            for (int hf = 0; hf < 2; ++hf) {
                f32x4 hh[16][2];
#pragma unroll
                for (int k2 = 0; k2 < 16; ++k2) { hh[k2][0] = *(const GAS f32x4*)(hrow + 32 * (16 * hf + k2)); hh[k2][1] = *(const GAS f32x4*)(hrow + 32 * (16 * hf + k2) + 4); }
#pragma unroll
                for (int k2 = 0; k2 < 16; ++k2) { const int ks = 16 * hf + k2;
                    const f32x4 g0 = *(const LAS f32x4*)(gl + 32 * ks), g1 = *(const LAS f32x4*)(gl + 32 * ks + 4);
                    const f32x4 x0 = hh[k2][0] * rstd * g0, x1 = hh[k2][1] * rstd * g1;
                    u32x4 hi; hi.x = cvt_pk_bf16(x0[0], x0[1]); hi.y = cvt_pk_bf16(x0[2], x0[3]); hi.z = cvt_pk_bf16(x1[0], x1[1]); hi.w = cvt_pk_bf16(x1[2], x1[3]);
                    *(GAS u32x4*)(xrow + 32 * ks) = hi;
                    u32x4 lo; lo.x = cvt_pk_bf16(x0[0] - bflo(hi.x), x0[1] - bfhi(hi.x)); lo.y = cvt_pk_bf16(x0[2] - bflo(hi.y), x0[3] - bfhi(hi.y));
                    lo.z = cvt_pk_bf16(x1[0] - bflo(hi.z), x1[1] - bfhi(hi.z)); lo.w = cvt_pk_bf16(x1[2] - bflo(hi.w), x1[3] - bfhi(hi.w));
                    const bf16x8 ahi = __builtin_bit_cast(bf16x8, hi), alo = __builtin_bit_cast(bf16x8, lo);
#pragma unroll
                    for (int nt = 0; nt < 3; ++nt) {
                        const int er = (16 * nt + tr) < 36 ? (16 * nt + tr) : 35;
                        const LAS unsigned char* wp = lds + er * 2048 + (((4 * ks + g) ^ (er & 15)) << 4);
                        const bf16x8 bh = *(const LAS bf16x8*)wp, bl = *(const LAS bf16x8*)(wp + WLO_OFF);
                        acc[nt] = __builtin_amdgcn_mfma_f32_16x16x32_bf16(ahi, bh, acc[nt], 0, 0, 0);
                        acc[nt] = __builtin_amdgcn_mfma_f32_16x16x32_bf16(ahi, bl, acc[nt], 0, 0, 0);
                        acc[nt] = __builtin_amdgcn_mfma_f32_16x16x32_bf16(alo, bh, acc[nt], 0, 0, 0);
                    }
                }
            }
            PT_END(40)
        }
        __syncthreads();
        if (act) {
#pragma unroll
            for (int nt = 0; nt < 3; ++nt)
#pragma unroll
                for (int i = 0; i < 4; ++i) lg[(4 * g + i) * 48 + 16 * nt + tr] = acc[nt][i];
            LDS_WAIT();
            if (lane < 16) {
                const LAS float* l = lg + lane * 48;
                float gl[4];
#pragma unroll
                for (int i = 0; i < 4; ++i) gl[i] = l[i] + brg[i];
                int gs = 0; float gm = gl[0];
#pragma unroll
                for (int i = 1; i < 4; ++i) if (gl[i] > gm) { gm = gl[i]; gs = i; }
                float gsum = 0.f;
#pragma unroll
                for (int i = 0; i < 4; ++i) gsum += __expf(gl[i] - gm);
                const float pg = 1.f / gsum;
                float el[8];
#pragma unroll
                for (int i = 0; i < 8; ++i) el[i] = l[4 + gs * 8 + i] + bre[gs * 8 + i];
                float em = el[0];
#pragma unroll
                for (int i = 1; i < 8; ++i) em = fmaxf(em, el[i]);
                float pe[8], esum = 0.f;
#pragma unroll
                for (int i = 0; i < 8; ++i) { pe[i] = __expf(el[i] - em); esum += pe[i]; }
#pragma unroll
                for (int i = 0; i < 8; ++i) pe[i] /= esum;
                int i1 = 0; float v1 = pe[0];
#pragma unroll
                for (int i = 1; i < 8; ++i) if (pe[i] > v1) { v1 = pe[i]; i1 = i; }
                int i2 = -1; float v2 = -1.f;
#pragma unroll
                for (int i = 0; i < 8; ++i) if (i != i1 && pe[i] > v2) { v2 = pe[i]; i2 = i; }
                const float tw = v1 + v2;
                w1 = v1 / tw * pg; w2 = v2 / tw * pg; e1 = gs * 8 + i1; e2 = gs * 8 + i2;
                p1 = (int)__hip_atomic_fetch_add((LAS unsigned*)&lcnt[e1], 1u, __ATOMIC_RELAXED, __HIP_MEMORY_SCOPE_WORKGROUP);
                p2 = (int)__hip_atomic_fetch_add((LAS unsigned*)&lcnt[e2], 1u, __ATOMIC_RELAXED, __HIP_MEMORY_SCOPE_WORKGROUP);
            }
        }
        __syncthreads();
        if (tid < NEXP) { const unsigned c = lcnt[tid]; lbase[tid] = c ? __hip_atomic_fetch_add(gcnt + tid, c, __ATOMIC_RELAXED, __HIP_MEMORY_SCOPE_AGENT) : 0u; lcnt[tid] = 0u; }
        __syncthreads();
        if (act && lane < 16) {
            const int s1 = e1 * NTOK + (int)lbase[e1] + p1, s2 = e2 * NTOK + (int)lbase[e2] + p2;
            LIST[s1] = tok * 2; LW[s1] = w1; LIST[s2] = tok * 2 + 1; LW[s2] = w2;
        }
        __syncthreads();
    }
}
namespace at {
typedef const LAS char* lds_cptr;
typedef short v4i16_t __attribute__((ext_vector_type(4)));
__device__ __forceinline__ int crow(int r, int hi) { return (r & 3) + 8 * (r >> 2) + 4 * hi; }
__device__ __forceinline__ void glds16(const void* gsrc, unsigned lds_dst) { unsigned keep;
    asm volatile("s_mov_b32 %0, m0\n\ts_mov_b32 m0, %2\n\ts_nop 0\n\tglobal_load_lds_dwordx4 %1, off\n\ts_mov_b32 m0, %0" : "=&s"(keep) : "v"(gsrc), "s"(lds_dst) : "memory"); }
#define AT_WAIT_BAR() asm volatile("s_waitcnt vmcnt(0) lgkmcnt(0)\n\ts_barrier" ::: "memory")
#define AT_BAR() asm volatile("s_waitcnt lgkmcnt(0)\n\ts_barrier" ::: "memory")
__device__ __forceinline__ unsigned cvtpk(float lo, float hi) { typedef float f2 __attribute__((ext_vector_type(2))); typedef __bf16 b2 __attribute__((ext_vector_type(2))); f2 v = {lo, hi}; b2 b = __builtin_convertvector(v, b2); return __builtin_bit_cast(unsigned, b); }
__device__ __forceinline__ s16x4 vtr(lds_cptr p) { return __builtin_bit_cast(s16x4, __builtin_amdgcn_ds_read_tr16_b64_v4i16((LAS v4i16_t*)p)); }

__device__ __forceinline__ int kpiece(int r32, int hi, int d0) { return ((2 * d0 + hi) ^ (r32 & 7)) * 16; }
__device__ __forceinline__ int ksrc_piece(int lane) { return ((lane & 7) ^ (lane >> 3)) * 8; }
__device__ __forceinline__ void qkt(f32x16& p0, f32x16& p1, lds_cptr Kslot, const bf16x8* qr, int r32, int hi) {
    lds_cptr kb = Kslot + r32 * 128;
    p0 = (f32x16){}; p1 = (f32x16){};
#pragma unroll
    for (int d0 = 0; d0 < 4; ++d0) {
        const bf16x8 b0 = *(const LAS bf16x8*)(kb + kpiece(r32, hi, d0));
        const bf16x8 b1 = *(const LAS bf16x8*)(kb + kpiece(r32, hi, d0) + 4096);
        p0 = __builtin_amdgcn_mfma_f32_32x32x16_bf16(b0, qr[d0], p0, 0, 0, 0);
        p1 = __builtin_amdgcn_mfma_f32_32x32x16_bf16(b1, qr[d0], p1, 0, 0, 0);
    }
}
__device__ __forceinline__ int vlane(int lane) { const int hi = lane >> 5; return ((lane >> 4) & 1) * 32 + (lane & 3) * 8 + (4 * hi + ((lane & 15) >> 2)) * 64; }
template <int NB> __device__ __forceinline__ void pv(f32x16* o, lds_cptr vp, const u32x4& pw0, const u32x4& pw1, const u32x4& pw2, const u32x4& pw3) {
#pragma unroll
    for (int d0 = 0; d0 < NB; ++d0) { s16x4 lo[4], hi[4];
#pragma unroll
        for (int ks = 0; ks < 4; ++ks) { lo[ks] = vtr(vp + d0 * 4096 + ks * 1024); hi[ks] = vtr(vp + d0 * 4096 + ks * 1024 + 512); }
#define AT_PK(k) (bf16x8){lo[k][0], lo[k][1], lo[k][2], lo[k][3], hi[k][0], hi[k][1], hi[k][2], hi[k][3]}
        o[d0] = __builtin_amdgcn_mfma_f32_32x32x16_bf16(__builtin_bit_cast(bf16x8, pw0), AT_PK(0), o[d0], 0, 0, 0);
        o[d0] = __builtin_amdgcn_mfma_f32_32x32x16_bf16(__builtin_bit_cast(bf16x8, pw1), AT_PK(1), o[d0], 0, 0, 0);
        o[d0] = __builtin_amdgcn_mfma_f32_32x32x16_bf16(__builtin_bit_cast(bf16x8, pw2), AT_PK(2), o[d0], 0, 0, 0);
        o[d0] = __builtin_amdgcn_mfma_f32_32x32x16_bf16(__builtin_bit_cast(bf16x8, pw3), AT_PK(3), o[d0], 0, 0, 0);
#undef AT_PK
    }
}
__device__ __forceinline__ void load_k(bf16x8 (&kf)[8], lds_cptr Kslot, int r32, int hi) {
    lds_cptr kb = Kslot + r32 * 128;
#pragma unroll
    for (int d0 = 0; d0 < 4; ++d0) { kf[2 * d0] = *(const LAS bf16x8*)(kb + kpiece(r32, hi, d0)); kf[2 * d0 + 1] = *(const LAS bf16x8*)(kb + kpiece(r32, hi, d0) + 4096); }
}
__device__ __forceinline__ void qkt_r(f32x16& p0, f32x16& p1, const bf16x8 (&kf)[8], const bf16x8* qr) {
    p0 = (f32x16){}; p1 = (f32x16){};
#pragma unroll
    for (int d0 = 0; d0 < 4; ++d0) { p0 = __builtin_amdgcn_mfma_f32_32x32x16_bf16(kf[2 * d0], qr[d0], p0, 0, 0, 0); p1 = __builtin_amdgcn_mfma_f32_32x32x16_bf16(kf[2 * d0 + 1], qr[d0], p1, 0, 0, 0); }
}
__device__ __forceinline__ int vlane2(int lane, int d0) { const int hi = lane >> 5, q = (lane & 15) >> 2; return (4 * hi + q) * 128 + ((d0 ^ ((q >> 1) & 1)) * 64) + ((lane >> 4) & 1) * 32 + (lane & 3) * 8; }
__device__ __forceinline__ int vsrc_piece(int lane) { return ((lane & 7) ^ ((((lane >> 3) >> 1) & 1) << 2)) * 8; }
__device__ __forceinline__ void load_v2(s16x4 (&vlo)[8], s16x4 (&vhi)[8], lds_cptr slot, int va0, int va1) {
#pragma unroll
    for (int d0 = 0; d0 < 2; ++d0)
#pragma unroll
        for (int ks = 0; ks < 4; ++ks) { vlo[d0 * 4 + ks] = vtr(slot + (d0 ? va1 : va0) + ks * 2048); vhi[d0 * 4 + ks] = vtr(slot + (d0 ? va1 : va0) + ks * 2048 + 1024); }
}
__device__ __forceinline__ void pv2_r(f32x16* o, const s16x4 (&vlo)[8], const s16x4 (&vhi)[8], const u32x4& pw0, const u32x4& pw1, const u32x4& pw2, const u32x4& pw3) {
#define AT_PKR(i) (bf16x8){vlo[i][0], vlo[i][1], vlo[i][2], vlo[i][3], vhi[i][0], vhi[i][1], vhi[i][2], vhi[i][3]}
#pragma unroll
    for (int d0 = 0; d0 < 2; ++d0) {
        o[d0] = __builtin_amdgcn_mfma_f32_32x32x16_bf16(__builtin_bit_cast(bf16x8, pw0), AT_PKR(d0 * 4 + 0), o[d0], 0, 0, 0);
        o[d0] = __builtin_amdgcn_mfma_f32_32x32x16_bf16(__builtin_bit_cast(bf16x8, pw1), AT_PKR(d0 * 4 + 1), o[d0], 0, 0, 0);
        o[d0] = __builtin_amdgcn_mfma_f32_32x32x16_bf16(__builtin_bit_cast(bf16x8, pw2), AT_PKR(d0 * 4 + 2), o[d0], 0, 0, 0);
        o[d0] = __builtin_amdgcn_mfma_f32_32x32x16_bf16(__builtin_bit_cast(bf16x8, pw3), AT_PKR(d0 * 4 + 3), o[d0], 0, 0, 0); }
#undef AT_PKR
}
__device__ __forceinline__ void qkt_ri(f32x16& p0, f32x16& p1, const bf16x8 (&kf)[8], const bf16x8* qr, const f32x16& i0, const f32x16& i1) {
    p0 = __builtin_amdgcn_mfma_f32_32x32x16_bf16(kf[0], qr[0], i0, 0, 0, 0); p1 = __builtin_amdgcn_mfma_f32_32x32x16_bf16(kf[1], qr[0], i1, 0, 0, 0);
#pragma unroll
    for (int d0 = 1; d0 < 4; ++d0) { p0 = __builtin_amdgcn_mfma_f32_32x32x16_bf16(kf[2 * d0], qr[d0], p0, 0, 0, 0); p1 = __builtin_amdgcn_mfma_f32_32x32x16_bf16(kf[2 * d0 + 1], qr[d0], p1, 0, 0, 0); }
}
__device__ __forceinline__ float rowmax32(const f32x16& p0, const f32x16& p1) {
    float a = fmaxf(p0[0], p1[0]);
#pragma unroll
    for (int r = 1; r < 16; ++r) a = fmaxf(a, fmaxf(p0[r], p1[r]));
    auto rr = __builtin_amdgcn_permlane32_swap(__float_as_uint(a), __float_as_uint(a), false, false);
    return fmaxf(__uint_as_float(rr[0]), __uint_as_float(rr[1]));
}
template <int NB> __device__ __forceinline__ void softmax_step(f32x16& p0, f32x16& p1, float& m, float& l, f32x16* o, LAS float* wsf, int r32, int hi, u32x4& pw0, u32x4& pw1, u32x4& pw2, u32x4& pw3) {
    const float rm = rowmax32(p0, p1);
    const float mn = fmaxf(m, rm);
    const float alpha = __builtin_amdgcn_exp2f(m - mn);
    m = mn;
    const bool resc = !__all(alpha == 1.f);
    if (resc && hi == 0) wsf[r32] = alpha;
    float s = 0.f;
#pragma unroll
    for (int r = 0; r < 16; ++r) { p0[r] = __builtin_amdgcn_exp2f(p0[r] - mn); p1[r] = __builtin_amdgcn_exp2f(p1[r] - mn); s += p0[r] + p1[r]; }
    l = l * alpha + s;
    pw0 = (u32x4){cvtpk(p0[0], p0[1]), cvtpk(p0[2], p0[3]), cvtpk(p0[4], p0[5]), cvtpk(p0[6], p0[7])};
    pw1 = (u32x4){cvtpk(p0[8], p0[9]), cvtpk(p0[10], p0[11]), cvtpk(p0[12], p0[13]), cvtpk(p0[14], p0[15])};
    pw2 = (u32x4){cvtpk(p1[0], p1[1]), cvtpk(p1[2], p1[3]), cvtpk(p1[4], p1[5]), cvtpk(p1[6], p1[7])};
    pw3 = (u32x4){cvtpk(p1[8], p1[9]), cvtpk(p1[10], p1[11]), cvtpk(p1[12], p1[13]), cvtpk(p1[14], p1[15])};
    if (resc) {
        LDS_WAIT();
#pragma unroll
        for (int g = 0; g < 4; ++g) { const f32x4 a = *(const LAS f32x4*)(wsf + 8 * g + 4 * hi);
#pragma unroll
            for (int d = 0; d < NB; ++d) { o[d][4 * g + 0] *= a[0]; o[d][4 * g + 1] *= a[1]; o[d][4 * g + 2] *= a[2]; o[d][4 * g + 3] *= a[3]; } }
    }
}
template <int NB> __device__ __forceinline__ bool softmax_def(f32x16& p0, f32x16& p1, float& mh, float& l, f32x16* o, LAS float* wsf, int r32, int hi, bool first, u32x4& pw0, u32x4& pw1, u32x4& pw2, u32x4& pw3) {
    const float rm = rowmax32(p0, p1);
    const bool trig = first || __any(rm > 8.f);
    if (trig) {
        const float dl = first ? rm : fmaxf(rm, 0.f);
        mh += dl;
#pragma unroll
        for (int r = 0; r < 16; ++r) { p0[r] -= dl; p1[r] -= dl; }
        if (!first) {
            const float f = __builtin_amdgcn_exp2f(-dl);
            l *= f;
            if (hi == 0) wsf[r32] = f;
            LDS_WAIT();
#pragma unroll
            for (int g = 0; g < 4; ++g) { const f32x4 a = *(const LAS f32x4*)(wsf + 8 * g + 4 * hi);
#pragma unroll
                for (int d = 0; d < NB; ++d) { o[d][4 * g + 0] *= a[0]; o[d][4 * g + 1] *= a[1]; o[d][4 * g + 2] *= a[2]; o[d][4 * g + 3] *= a[3]; } }
        }
    }
    float s = 0.f;
#pragma unroll
    for (int r = 0; r < 16; ++r) { p0[r] = __builtin_amdgcn_exp2f(p0[r]); p1[r] = __builtin_amdgcn_exp2f(p1[r]); s += p0[r] + p1[r]; }
    l += s;
    pw0 = (u32x4){cvtpk(p0[0], p0[1]), cvtpk(p0[2], p0[3]), cvtpk(p0[4], p0[5]), cvtpk(p0[6], p0[7])};
    pw1 = (u32x4){cvtpk(p0[8], p0[9]), cvtpk(p0[10], p0[11]), cvtpk(p0[12], p0[13]), cvtpk(p0[14], p0[15])};
    pw2 = (u32x4){cvtpk(p1[0], p1[1]), cvtpk(p1[2], p1[3]), cvtpk(p1[4], p1[5]), cvtpk(p1[6], p1[7])};
    pw3 = (u32x4){cvtpk(p1[8], p1[9]), cvtpk(p1[10], p1[11]), cvtpk(p1[12], p1[13]), cvtpk(p1[14], p1[15])};
    return trig;
}
__device__ __forceinline__ void row_scales(float l, LAS float* wsf, int r32, int hi, float scale, float (&rl)[16]) {
    auto rr = __builtin_amdgcn_permlane32_swap(__float_as_uint(l), __float_as_uint(l), false, false);
    const float lt = __uint_as_float(rr[0]) + __uint_as_float(rr[1]);
    LDS_WAIT();
    if (hi == 0) wsf[32 + r32] = scale * __builtin_amdgcn_rcpf(lt);
    LDS_WAIT();
#pragma unroll
    for (int g = 0; g < 4; ++g) { const f32x4 a = *(const LAS f32x4*)(wsf + 32 + 8 * g + 4 * hi); rl[4 * g] = a[0]; rl[4 * g + 1] = a[1]; rl[4 * g + 2] = a[2]; rl[4 * g + 3] = a[3]; }
}
}

__device__ __forceinline__ void attn_c_phase(LAS unsigned char* lds, const bf16_t* QKV, const float* rel, bf16_t* ATT, int vcu, int G, int wave, int lane, int tid) {
    using namespace at;
    constexpr int WS_OFF = 98304, OST_OFF = 0;
    const int r32 = lane & 31, hi = lane >> 5;
    const int hh = wave >> 2, cc = (wave >> 1) & 1, rh = wave & 1;
    LAS float* wsf = (LAS float*)(lds + WS_OFF) + wave * 64;
    LAS float* tab = (LAS float*)(lds + TAB_OFF);
    const unsigned lds0 = (unsigned)(uintptr_t)lds;
    const int va0 = vlane2(lane, 0), va1 = vlane2(lane, 1);
    constexpr int NUNIT = BATCH * 8 * 32;
    int cur_hp = -1;
    for (int u = vcu; u < NUNIT; u += G) {
        const int b = u >> 8, hp = (u >> 5) & 7, cp = u & 31;
        if (hp != cur_hp) {
            AT_BAR();
            for (int i = tid; i < 2 * 640; i += NWAVES * 64) { const int h2 = i / 640, idx = i % 640; int d = idx - 63; d = d < -128 ? -128 : (d > 128 ? 128 : d); tab[i] = rel[(d + 128) * 16 + 2 * hp + h2] * LOG2E; }
            cur_hp = hp;
            AT_BAR();
        }
        const int head = 2 * hp + hh, qchunk = 2 * cp + cc;
        const size_t rowbase = (size_t)b * SEQ;
        bf16x8 qr[4];
        { const bf16_t* qp = QKV + (rowbase + qchunk * 64 + 32 * rh + r32) * C_IN + head * 64 + 8 * hi;
#pragma unroll
          for (int d0 = 0; d0 < 4; ++d0) qr[d0] = *(const GAS bf16x8*)(qp + 16 * d0); }
        const int j0 = (2 * cp - 8 < 0) ? (8 - 2 * cp) : 0;
        const bf16_t* ksrc = QKV + (rowbase + 8 * wave + (lane >> 3)) * C_IN + 1024 + (2 * hp) * 64 + ksrc_piece(lane);
        const bf16_t* vsrc = QKV + (rowbase + 8 * wave + (lane >> 3)) * C_IN + 2048 + (2 * hp) * 64 + vsrc_piece(lane);
#define DMA_TILE(j, buf) do { const size_t ro_ = (size_t)((2 * cp - 8 + (j)) * 64) * C_IN; const unsigned d_ = (unsigned)__builtin_amdgcn_readfirstlane(lds0 + (buf) * 32768 + wave * 1024); \
        glds16(ksrc + ro_, d_); glds16(ksrc + ro_ + 64, d_ + 8192); glds16(vsrc + ro_, d_ + 16384); glds16(vsrc + ro_ + 64, d_ + 24576); } while (0)
        float mh = 0.f, l = 0.f; f32x16 o[2]; o[0] = (f32x16){}; o[1] = (f32x16){};
        const float cb = tab[hh * 640 + 63 + 128]; f32x16 cfar; bool first = true;
#pragma unroll
        for (int r = 0; r < 16; ++r) cfar[r] = cb;
        DMA_TILE(j0, 0); if (j0 + 1 < 10) DMA_TILE(j0 + 1, 1);
        int buf = 0; bool have_k = false; bf16x8 kf[8];
        for (int j = j0; j < 10; ++j) {
            AT_WAIT_BAR();
            if (j + 2 < 10) DMA_TILE(j + 2, (buf == 0) ? 2 : buf - 1);
            const int bufn = (buf == 2) ? 0 : buf + 1;
            const bool act = (j >= cc && j <= cc + 8), actn = (j + 1 < 10) && (j + 1 >= cc && j + 1 <= cc + 8);
            if (act) {
                lds_cptr Vs = (lds_cptr)(lds + buf * 32768 + 16384 + hh * 8192);
                if (!have_k) load_k(kf, (lds_cptr)(lds + buf * 32768 + hh * 8192), r32, hi);
                s16x4 vlo[8], vhi[8];
                load_v2(vlo, vhi, Vs, va0, va1);
                const int dl = cc + 8 - j;
                f32x16 p0, p1;
                if (dl >= 3) qkt_ri(p0, p1, kf, qr, cfar, cfar);
                else { const LAS float* tp = tab + hh * 640 + (dl * 64 + 32 * rh + r32 - 4 * hi);
                    f32x16 b0, b1;
#pragma unroll
                    for (int r = 0; r < 16; ++r) { b0[r] = tp[63 - ((r & 3) + 8 * (r >> 2))] - mh; b1[r] = tp[31 - ((r & 3) + 8 * (r >> 2))] - mh; }
                    qkt_ri(p0, p1, kf, qr, b0, b1); }
                if (actn) load_k(kf, (lds_cptr)(lds + bufn * 32768 + hh * 8192), r32, hi);
                u32x4 pw0, pw1, pw2, pw3;
                if (softmax_def<2>(p0, p1, mh, l, o, wsf, r32, hi, first, pw0, pw1, pw2, pw3)) {
#pragma unroll
                    for (int r = 0; r < 16; ++r) cfar[r] = cb - mh; }
                first = false;
                pv2_r(o, vlo, vhi, pw0, pw1, pw2, pw3);
            } else if (actn) load_k(kf, (lds_cptr)(lds + bufn * 32768 + hh * 8192), r32, hi);
            have_k = actn;
            buf = bufn;
        }
#undef DMA_TILE
        float rl[16]; row_scales(l, wsf, r32, hi, 1.f, rl);
        AT_BAR();
        { LAS bf16_t* stg = (LAS bf16_t*)(lds + OST_OFF) + wave * 2048;
#pragma unroll
          for (int r = 0; r < 16; ++r) { const int orow = crow(r, hi);
#pragma unroll
              for (int d0 = 0; d0 < 2; ++d0) stg[orow * 64 + d0 * 32 + r32] = (bf16_t)f2bf(o[d0][r] * rl[r]); }
          LDS_WAIT();
          bf16_t* Ow = ATT + (rowbase + qchunk * 64 + 32 * rh) * D + head * 64;
#pragma unroll
          for (int i = 0; i < 4; ++i) { const int row = i * 8 + (lane >> 3), ch = lane & 7; const u32x4 v = *(const LAS u32x4*)(stg + row * 64 + ch * 8); *(GAS u32x4*)(Ow + (size_t)row * D + ch * 8) = v; } }
        AT_BAR();
    }
}

constexpr int BG_TILES = 64 * 384;
struct BgConv { const float* wg; const float* wu; const float* wd; bf16_t* WGU; bf16_t* WD; int G, bx, next, issued; unsigned off; };
#define BG_VMW(k) asm volatile("s_waitcnt vmcnt(" #k ")" ::: "memory")
__device__ __forceinline__ void wait_vm(int n) {
    if (n >= 11) BG_VMW(11); else if (n == 10) BG_VMW(10); else if (n == 9) BG_VMW(9); else if (n == 8) BG_VMW(8); else if (n == 7) BG_VMW(7); else if (n == 6) BG_VMW(6);
    else if (n == 5) BG_VMW(5); else if (n == 4) BG_VMW(4); else if (n == 3) BG_VMW(3); else if (n == 2) BG_VMW(2); else if (n == 1) BG_VMW(1); else BG_VMW(0);
}
__device__ __forceinline__ void bg_issue(const BgConv& bg, unsigned lds0, int bt, int slot, int wave, int lane) {
    const int le = bt / 384, r = bt - le * 384, m = r >> 7, q = r & 127;
    const float* src; int N, k0, n0;
    if (m < 2) { src = (m ? bg.wu : bg.wg) + (size_t)le * D * DEXP; N = DEXP; k0 = 64 * (q >> 3) + 8 * wave; n0 = 64 * (q & 7); }
    else { src = bg.wd + (size_t)le * DEXP * D; N = D; k0 = 64 * (q >> 4) + 8 * wave; n0 = 64 * (q & 15); }
    const float* p = src + (size_t)(k0 + (lane >> 4)) * N + n0 + 4 * (lane & 15);
    const unsigned d = (unsigned)__builtin_amdgcn_readfirstlane(lds0 + bg.off + slot * 2048);
    at::glds16(p, d); at::glds16(p + 4 * N, d + 1024);
}
__device__ __forceinline__ void bg_consume(const BgConv& bg, LAS unsigned char* lds, int bt, int slot, int wave, int lane) {
    const int le = bt / 384, r = bt - le * 384, m = r >> 7, q = r & 127;
    const LAS float* s = (const LAS float*)(lds + bg.off + slot * 2048) + lane;
    float v[8];
#pragma unroll
    for (int kk = 0; kk < 8; ++kk) v[kk] = s[kk * 64];
    u32x4 o; o.x = cvt_pk_bf16(v[0], v[1]); o.y = cvt_pk_bf16(v[2], v[3]); o.z = cvt_pk_bf16(v[4], v[5]); o.w = cvt_pk_bf16(v[6], v[7]);
    bf16_t* dst;
    if (m < 2) { const int n = 64 * (q & 7) + lane; dst = bg.WGU + (size_t)le * 1024 * D + (size_t)(256 * (n >> 7) + 128 * m + (n & 127)) * D + 64 * (q >> 3) + 8 * wave; }
    else { const int n = 64 * (q & 15) + lane; dst = bg.WD + (size_t)le * D * DEXP + (size_t)n * DEXP + 64 * (q >> 4) + 8 * wave; }
    *(GAS u32x4*)dst = o;
}

__device__ __forceinline__ void attn_a_build_tab(LAS unsigned char* lds, const float* t5, int tid) {
    LAS float* tab = (LAS float*)(lds + TAB_OFF);
    for (int i = tid; i < 4 * 768; i += NWAVES * 64) { const int h = i / 768, d = (i % 768) - 63; tab[i] = t5[t5_bucket(-d) * 12 + h] * LOG2E; }
}
__device__ __forceinline__ void attn_a_unit(LAS unsigned char* lds, const bf16_t* PROJ, const float* subln, float lam, bf16_t* ATT, int b, int h, int qb, int wave, int lane, BgConv& bg) {
    using namespace at;
    constexpr int WS_OFF = 98304, XROW = 132;
    const int r32 = lane & 31, hi = lane >> 5;
    const int mm = wave & 1, rg = wave >> 1;
    LAS float* wsf = (LAS float*)(lds + WS_OFF) + wave * 64;
    const LAS float* tab = (const LAS float*)(lds + TAB_OFF) + h * 768;
    const unsigned lds0 = (unsigned)(uintptr_t)lds;
    const int va0 = vlane2(lane, 0), va1 = vlane2(lane, 1);
    const size_t rowbase = (size_t)b * SEQ;
    const int qw0 = 128 * qb + 32 * rg;
    const int cq = qw0 >> 6;
    const int NT = 2 * qb + 2;
    bf16x8 qr[4];
    { const bf16_t* qp = PROJ + (rowbase + qw0 + r32) * AB_INP + h * 128 + mm * 64 + 8 * hi;
#pragma unroll
      for (int d0 = 0; d0 < 4; ++d0) qr[d0] = *(const GAS bf16x8*)(qp + 16 * d0); }
    const bf16_t* ksrc = PROJ + (rowbase + 8 * wave + (lane >> 3)) * AB_INP + 512 + h * 128 + ksrc_piece(lane);
    const bf16_t* vsrc0 = PROJ + (rowbase + 8 * (wave >> 1) + (lane >> 3)) * AB_INP + 1024 + h * 128 + (wave & 1) * 64 + vsrc_piece(lane);
    const bf16_t* vsrc1 = vsrc0 + (size_t)32 * AB_INP;
#define DMA_TILE(t, buf) do { const size_t ro_ = (size_t)((t) * 64) * AB_INP; const unsigned d_ = (unsigned)__builtin_amdgcn_readfirstlane(lds0 + (buf) * 32768 + wave * 1024); \
        const unsigned dv_ = (unsigned)__builtin_amdgcn_readfirstlane(lds0 + (buf) * 32768 + 16384 + (wave & 1) * 8192 + (wave >> 1) * 1024); \
        glds16(ksrc + ro_, d_); glds16(ksrc + ro_ + 64, d_ + 8192); glds16(vsrc0 + ro_, dv_); glds16(vsrc1 + ro_, dv_ + 4096); } while (0)
    float mh = 0.f, l = 0.f; f32x16 o[4]; o[0] = (f32x16){}; o[1] = (f32x16){}; o[2] = (f32x16){}; o[3] = (f32x16){};
    const float c15 = tab[700];
    bool first = true;
    int mD0, mD1, mD2, mB = 0, btPrev = 0; bool aPrev = false;
    DMA_TILE(0, 0); bg.issued += 4; mD0 = bg.issued; DMA_TILE(1, 1); bg.issued += 4; mD1 = bg.issued;
    int buf = 0;
    for (int t = 0; t < NT; ++t) {
        wait_vm(bg.issued - mD0); AT_BAR();
        if (t + 2 < NT) { DMA_TILE(t + 2, (buf == 0) ? 2 : buf - 1); bg.issued += 4; }
        mD2 = bg.issued;
        bool aCur = false; int btCur = 0;
        if (t + 1 < NT) { btCur = bg.next * bg.G + bg.bx; if (btCur < BG_TILES) { bg_issue(bg, lds0, btCur, t & 1, wave, lane); bg.issued += 2; aCur = true; ++bg.next; } }
        const int mBcur = bg.issued;
        if (t <= cq) {
            lds_cptr Vs = (lds_cptr)(lds + buf * 32768 + 16384);
            f32x16 p0, p1;
            { bf16x8 kf[8];
              load_k(kf, (lds_cptr)(lds + buf * 32768 + mm * 8192), r32, hi);
              const int dmin = qw0 - (64 * t + 63);
              f32x16 b0, b1;
              if (dmin >= 559) { const float c = c15 - mh;
#pragma unroll
                  for (int r = 0; r < 16; ++r) b0[r] = c;
                  qkt_ri(p0, p1, kf, qr, b0, b0); }
              else { const LAS float* tp = tab + (qw0 - 64 * t + r32 - 4 * hi);
#pragma unroll
                  for (int r = 0; r < 16; ++r) { b0[r] = tp[63 - ((r & 3) + 8 * (r >> 2))] - mh; b1[r] = tp[31 - ((r & 3) + 8 * (r >> 2))] - mh; }
                  qkt_ri(p0, p1, kf, qr, b0, b1); } }
            s16x4 vlo[8], vhi[8];
            load_v2(vlo, vhi, Vs, va0, va1);
            u32x4 pw0, pw1, pw2, pw3;
            (void)softmax_def<4>(p0, p1, mh, l, o, wsf, r32, hi, first, pw0, pw1, pw2, pw3);
            first = false;
            pv2_r(o, vlo, vhi, pw0, pw1, pw2, pw3);
            load_v2(vlo, vhi, Vs + 8192, va0, va1);
            pv2_r(o + 2, vlo, vhi, pw0, pw1, pw2, pw3);
        }
        if (aPrev) { wait_vm(bg.issued - mB); bg_consume(bg, lds, btPrev, (t - 1) & 1, wave, lane); bg.issued += 1; }
        aPrev = aCur; btPrev = btCur; mB = mBcur; mD0 = mD1; mD1 = mD2;
        buf = (buf == 2) ? 0 : buf + 1;
    }
#undef DMA_TILE
    float rl[16]; row_scales(l, wsf, r32, hi, mm ? -lam : 1.f, rl);
    LAS float* X = (LAS float*)lds + rg * (32 * XROW);
    AT_BAR();
    if (mm == 1) {
#pragma unroll
        for (int blk = 0; blk < 4; ++blk)
#pragma unroll
            for (int r = 0; r < 16; ++r) X[crow(r, hi) * XROW + blk * 32 + r32] = o[blk][r] * rl[r];
    }
    AT_BAR();
    if (mm == 0) {
#pragma unroll
        for (int blk = 0; blk < 4; ++blk)
#pragma unroll
            for (int r = 0; r < 16; ++r) X[crow(r, hi) * XROW + blk * 32 + r32] += o[blk][r] * rl[r];
        LDS_WAIT();
        const int row = lane >> 1, half = lane & 1;
        const LAS float* xr = X + row * XROW + half * 64;
        f32x4 v[16]; float ss = 0.f;
#pragma unroll
        for (int k = 0; k < 16; ++k) { v[k] = *(const LAS f32x4*)(xr + 4 * k); ss += (v[k][0] * v[k][0] + v[k][1] * v[k][1]) + (v[k][2] * v[k][2] + v[k][3] * v[k][3]); }
        ss += __shfl_xor(ss, 1);
        const float sc = __builtin_amdgcn_rsqf(ss * (1.f / 128.f) + EPS) * 0.8f;
        bf16_t* op = ATT + (rowbase + qw0 + row) * D + h * 128 + half * 64;
        const float* sg = subln + half * 64;
#pragma unroll
        for (int k = 0; k < 8; ++k) { const f32x4 g0 = *(const GAS f32x4*)(sg + 8 * k), g1 = *(const GAS f32x4*)(sg + 8 * k + 4); const f32x4 a = v[2 * k] * sc * g0, c = v[2 * k + 1] * sc * g1;
            u32x4 w; w.x = cvt_pk_bf16(a[0], a[1]); w.y = cvt_pk_bf16(a[2], a[3]); w.z = cvt_pk_bf16(c[0], c[1]); w.w = cvt_pk_bf16(c[2], c[3]);
            *(GAS u32x4*)(op + 8 * k) = w; }
    }
    AT_BAR();
}
__device__ __forceinline__ void attn_a_phase(LAS unsigned char* lds, const bf16_t* PROJ, const float* t5, const float* subln, float lam, bf16_t* ATT, int vcu, int G, int wave, int lane, int tid, BgConv& bg) {
    AT_BAR();
    attn_a_build_tab(lds, t5, tid);
    AT_BAR();
    for (int p = vcu; p < 512; p += G) {
        const int bh = p >> 4, s = p & 15;
#pragma unroll 1
        for (int k = 0; k < 2; ++k) attn_a_unit(lds, PROJ, subln, lam, ATT, bh >> 2, bh & 3, k ? 31 - s : s, wave, lane, bg);
    }
#pragma unroll 1
    for (;;) { const int bt = bg.next * bg.G + bg.bx; if (bt >= BG_TILES) break; bg_issue(bg, (unsigned)(uintptr_t)lds, bt, 0, wave, lane); VM_WAIT(); bg_consume(bg, lds, bt, 0, wave, lane); LDS_WAIT(); ++bg.next; }
}

#ifndef BM_SELREP
#define BM_SELREP 1
#endif
#ifndef BM_ATTREP
#define BM_ATTREP 1
#endif
namespace bm {
using namespace at;
constexpr int GT_OFF = 0, EQ_OFF = 16384, CAND_OFF = 32768, CCNT_OFF = 32768 + 4096, SEL_OFF = 98304, VIMG_OFF = 0, QI_OFF = TAB_OFF + 10240, LOINV_OFF = TAB_OFF + 26624;
__device__ __forceinline__ unsigned sortable(float f) { const unsigned u = __float_as_uint(f); return (u & 0x80000000u) ? ~u : (u | 0x80000000u); }
__device__ __forceinline__ void load_kf(bf16x8 (&kf)[4], const bf16_t* kbase, int wave, int i, int r32, int hi) {
    const bf16_t* kp = kbase + (size_t)(64 * (wave + 8 * (i >> 1)) + 32 * (i & 1) + r32) * AB_INP + 8 * hi;
#pragma unroll
    for (int d0 = 0; d0 < 4; ++d0) kf[d0] = *(const GAS bf16x8*)(kp + 16 * d0);
}
__device__ __forceinline__ void half_scores(f32x16& a, const bf16x8 (&kf)[4], lds_cptr qfl, const float (&wq)[4]) {
    a = (f32x16){};
#pragma unroll
    for (int hh = 0; hh < 4; ++hh) { f32x16 p = (f32x16){};
#pragma unroll
        for (int d0 = 0; d0 < 4; ++d0) p = __builtin_amdgcn_mfma_f32_32x32x16_bf16(kf[d0], *(const LAS bf16x8*)(qfl + (hh * 4 + d0) * 1024), p, 0, 0, 0);
#pragma unroll
        for (int r = 0; r < 16; ++r) a[r] = __builtin_fmaf(fmaxf(p[r], 0.f), wq[hh], a[r]);
        __builtin_amdgcn_sched_barrier(0); }
}
__device__ __forceinline__ float unsortable(unsigned k) { return __uint_as_float((k & 0x80000000u) ? (k & 0x7fffffffu) : ~k); }
__device__ __forceinline__ int linbin0(float a, float lo, float invw) { int b = (int)((a - lo) * invw); b = b < 1 ? 1 : b; return b > 2046 ? 2046 : b; }
__device__ __forceinline__ int linbin(float a, float lo, float invw, int zb) { const int b = linbin0(a, lo, invw); return a > 0.f ? (b > zb ? b : zb) + 1 : (a == 0.f ? zb : (b < zb ? b : zb) - 1); }
__device__ __forceinline__ void unit(LAS unsigned char* lds, volatile LAS unsigned* MISC, const bf16_t* PROJ, bf16_t* ATT, unsigned* kc, int b, int qg, int wave, int lane_in, int tid_in) {
    const size_t rowbase = (size_t)b * SEQ;
    const int q0 = 32 * qg, ntile = (q0 >> 6) + 1, nk = 64 * ntile;
    const bf16_t* kbase = PROJ + rowbase * AB_INP + 2432;
    LAS unsigned short* sel = (LAS unsigned short*)(lds + SEL_OFF);
    LAS unsigned* hist = (LAS unsigned*)lds;
    const int ns = nk < 256 ? nk : 256;
    AT_BAR();
    __builtin_amdgcn_fence(__ATOMIC_ACQUIRE, "agent");
    bool fast = false;
    PT_BEGIN(1)
    PT_BEGIN(5)
    if (ntile > 4) {
        float wq[4];
        { const int r32 = lane_in & 31; const bf16_t* qp = PROJ + (rowbase + q0 + r32) * AB_INP;
#pragma unroll
          for (int hh = 0; hh < 4; ++hh) wq[hh] = bf2f(qp[2496 + hh]) * 0.0625f;
#pragma unroll
          for (int i = 0; i < 2; ++i) { const int pc = tid_in + 512 * i, q = pc & 31, hi2 = (pc >> 5) & 1, f = pc >> 6;
              *(LAS u32x4*)(lds + QI_OFF + pc * 16) = *(const GAS u32x4*)(PROJ + (rowbase + q0 + q) * AB_INP + 2176 + (f >> 2) * 64 + 16 * (f & 3) + 8 * hi2); }
#pragma unroll 1
          for (int i = 0; i < 16; ++i) *(LAS u32x4*)(lds + (i * 512 + tid_in) * 16) = (u32x4){0u, 0u, 0u, 0u};
          if (tid_in < 32) { MISC[128 + 2 * tid_in] = 0u; MISC[129 + 2 * tid_in] = 256u; }
          if (tid_in == 0) { MISC[248] = 0u; MISC[249] = 0u; } }
        AT_BAR();
        PT_END(1)
        PT_BEGIN(2)
        { int tid = tid_in, lane = lane_in; asm volatile("" : "+v"(tid), "+v"(lane));
          const int r32 = lane & 31, hi = lane >> 5;
          LAS unsigned* hq = hist + r32 * 1024;
          lds_cptr qfl = (lds_cptr)(lds + QI_OFF + hi * 512 + r32 * 16);
          const int nhalf = 2 * ((ntile - wave + NWAVES - 1) / NWAVES);
          GAS u32x4* kcw = (GAS u32x4*)kc + (size_t)(wave * 16) * 256 + lane;
          bf16x8 kf3[4][4];
          if (nhalf > 0) load_kf(kf3[0], kbase, wave, 0, r32, hi);
          if (nhalf > 1) load_kf(kf3[1], kbase, wave, 1, r32, hi);
          if (nhalf > 2) load_kf(kf3[2], kbase, wave, 2, r32, hi);
#pragma unroll 1
          for (int i0 = 0; i0 < nhalf; i0 += 4) {
#pragma unroll
              for (int u = 0; u < 4; ++u) { const int i = i0 + u;
                  if (i < nhalf) {
                      if (i + 3 < nhalf) load_kf(kf3[(u + 3) & 3], kbase, wave, i + 3, r32, hi);
                      f32x16 a;
                      half_scores(a, kf3[u], qfl, wq);
                      unsigned k[16];
#pragma unroll
                      for (int r = 0; r < 16; ++r) k[r] = sortable(a[r]);
#pragma unroll
                      for (int r4 = 0; r4 < 4; ++r4) kcw[(i * 4 + r4) * 64] = (u32x4){k[4 * r4], k[4 * r4 + 1], k[4 * r4 + 2], k[4 * r4 + 3]};
#pragma unroll
                      for (int r = 0; r < 16; ++r) { const unsigned bin = k[r] >> 21; (void)__hip_atomic_fetch_add(hq + (bin >> 1), 1u << ((bin & 1u) << 4), __ATOMIC_RELAXED, __HIP_MEMORY_SCOPE_WORKGROUP); }
                  } }
          } }
        AT_BAR();
        PT_END(2)
#define BM_SCAN(PASSV) do { const int q = tid >> 4, j = tid & 15; const LAS unsigned* hq0 = hist + q * 1024; const LAS unsigned* hqq = hq0 + (1024 - 64 * (j + 1)); \
            unsigned c = 0; \
            _Pragma("unroll 8") for (int d = 0; d < 64; ++d) { const unsigned w = hqq[(d + 4 * j + q) & 63]; c += (w & 0xffffu) + (w >> 16); } \
            unsigned cum = c; \
            _Pragma("unroll") for (int off = 1; off < 16; off <<= 1) { const unsigned tt = __shfl_up(cum, off, 16); if (j >= off) cum += tt; } \
            const unsigned need = MISC[129 + 2 * q], before = cum - c; \
            const bool own = (before < need && need <= cum); \
            const unsigned long long bal = __ballot(own); const int jstar = __builtin_ctzll((bal >> (tid & 48)) & 0xffffull); \
            const unsigned before_s = __shfl(before, jstar, 16); \
            const LAS unsigned* hqs = hq0 + (1024 - 64 * (jstar + 1)) + (60 - 4 * j);            \
            const u32x4 w4 = *(const LAS u32x4*)hqs; \
            const unsigned b7 = w4.w >> 16, b6 = w4.w & 0xffffu, b5 = w4.z >> 16, b4 = w4.z & 0xffffu, b3 = w4.y >> 16, b2 = w4.y & 0xffffu, b1 = w4.x >> 16, b0 = w4.x & 0xffffu;     \
            const unsigned c2 = ((b7 + b6) + (b5 + b4)) + ((b3 + b2) + (b1 + b0)); \
            unsigned cum2 = c2; \
            _Pragma("unroll") for (int off = 1; off < 16; off <<= 1) { const unsigned tt = __shfl_up(cum2, off, 16); if (j >= off) cum2 += tt; } \
            const unsigned bef2 = before_s + cum2 - c2; \
            if (bef2 < need && need <= bef2 + c2) { \
                const unsigned bv[8] = {b7, b6, b5, b4, b3, b2, b1, b0}; unsigned run = bef2, T = 0, nn = need, cT = 0; bool found = false; \
                const unsigned bintop = 2u * (unsigned)(1024 - 64 * (jstar + 1) + 63 - 4 * j) + 1u;                                       \
                _Pragma("unroll") for (int m = 0; m < 8; ++m) { if (!found) { if (run + bv[m] >= need) { T = bintop - m; nn = need - run; cT = bv[m]; found = true; } else run += bv[m]; } } \
                const unsigned prf = MISC[128 + 2 * q]; \
                MISC[128 + 2 * q] = ((PASSV) <= 0) ? T : ((prf << ((PASSV) == 1 ? 11 : 10)) | T); MISC[129 + 2 * q] = nn; \
                if ((PASSV) == 1) { const unsigned t22_ = (prf << 11) | T; const bool zb_ = (cT > 16u) && (t22_ == 0x200000u);        \
                    MISC[192 + q] = zb_ ? (0x10000u | cT) : cT; if (cT > 16u && !zb_) MISC[248] = 1u; } } } while (0)
        PT_BEGIN(6)
        { int tid = tid_in; asm volatile("" : "+v"(tid)); BM_SCAN(0); }
        AT_BAR();
        PT_END(6)
        PT_BEGIN(7)
#pragma unroll 1
        for (int pass = 1; pass < 4; ++pass) {
            if (pass == 2 && fast) break;
            const unsigned shift = pass == 0 ? 21u : (pass == 1 ? 10u : 0u), bmask = pass == 2 ? 1023u : 2047u, cshift = pass == 1 ? 21u : 10u;
            int tid = tid_in, lane = lane_in; asm volatile("" : "+v"(tid), "+v"(lane));
            const int r32 = lane & 31, hi = lane >> 5;
            AT_BAR();
            if (pass < 3) {
#pragma unroll 1
                for (int i = 0; i < 16; ++i) *(LAS u32x4*)(lds + (i * 512 + tid) * 16) = (u32x4){0u, 0u, 0u, 0u};
            }
            AT_BAR();
            const unsigned pref = MISC[128 + 2 * r32];
            LAS unsigned* hq = hist + r32 * 1024;
            const int nhalf = 2 * ((ntile - wave + NWAVES - 1) / NWAVES);
            GAS u32x4* kcw = (GAS u32x4*)kc + (size_t)(wave * 16) * 256 + lane;
            {
                u32x4 kq[4], kqn[4];
                if (nhalf > 0) {
#pragma unroll
                    for (int r4 = 0; r4 < 4; ++r4) kq[r4] = kcw[r4 * 64]; }
                unsigned gm0 = 0u, em0 = 0u;
#pragma unroll 1
                for (int i = 0; i < nhalf; ++i) {
                    const int t = wave + 8 * (i >> 1), sh = i & 1;
                    if (i + 1 < nhalf) {
#pragma unroll
                        for (int r4 = 0; r4 < 4; ++r4) kqn[r4] = kcw[((i + 1) * 4 + r4) * 64]; }
                    if (pass < 3) {
#pragma unroll
                        for (int r = 0; r < 16; ++r) { const unsigned key = kq[r >> 2][r & 3], bin = (key >> shift) & bmask;
                            if ((key >> cshift) == pref) (void)__hip_atomic_fetch_add(hq + (bin >> 1), 1u << ((bin & 1u) << 4), __ATOMIC_RELAXED, __HIP_MEMORY_SCOPE_WORKGROUP); }
                    } else {
                        unsigned g_ = 0u, e_ = 0u;
#pragma unroll
                        for (int r = 0; r < 16; ++r) { const unsigned key = kq[r >> 2][r & 3], bit = 1u << ((r & 3) + 8 * (r >> 2)); g_ |= (key > pref) ? bit : 0u; e_ |= (key == pref) ? bit : 0u; }
                        if (sh == 0) { gm0 = g_; em0 = e_; }
                        else {
                            unsigned glo = gm0 << (4 * hi), ghi = g_ << (4 * hi), elo = em0 << (4 * hi), ehi = e_ << (4 * hi);
                            glo |= __shfl_xor(glo, 32); ghi |= __shfl_xor(ghi, 32); elo |= __shfl_xor(elo, 32); ehi |= __shfl_xor(ehi, 32);
                            if (hi == 0) { *(LAS u32x2*)(lds + GT_OFF + (r32 * 64 + t) * 8) = (u32x2){glo, ghi}; *(LAS u32x2*)(lds + EQ_OFF + (r32 * 64 + t) * 8) = (u32x2){elo, ehi}; }
                        }
                    }
#pragma unroll
                    for (int r4 = 0; r4 < 4; ++r4) kq[r4] = kqn[r4];
                }
            }
            AT_BAR();
            if (pass < 3) { BM_SCAN(pass); AT_BAR(); }
            if (pass == 1 && MISC[248] == 0u) {
                fast = true;
            { int tid = tid_in, lane = lane_in; asm volatile("" : "+v"(tid), "+v"(lane));
              const int r32 = lane & 31, hi = lane >> 5;
              if (tid < 32) ((LAS unsigned*)(lds + CCNT_OFF))[tid] = 0u;
              AT_BAR();
              const unsigned T22 = MISC[128 + 2 * r32]; const bool tieq = (MISC[192 + r32] >> 16) != 0u;
              const int nhalf = 2 * ((ntile - wave + NWAVES - 1) / NWAVES);
              GAS u32x4* kcw = (GAS u32x4*)kc + (size_t)(wave * 16) * 256 + lane;
              u32x4 kq[4], kqn[4];
              if (nhalf > 0) {
#pragma unroll
                  for (int r4 = 0; r4 < 4; ++r4) kq[r4] = kcw[r4 * 64]; }
              unsigned gm0 = 0u, em0 = 0u;
#pragma unroll 1
              for (int i = 0; i < nhalf; ++i) {
                  const int t = wave + 8 * (i >> 1), sh = i & 1;
                  if (i + 1 < nhalf) {
#pragma unroll
                      for (int r4 = 0; r4 < 4; ++r4) kqn[r4] = kcw[((i + 1) * 4 + r4) * 64]; }
                  unsigned g_ = 0u, e_ = 0u;
#pragma unroll
                  for (int r = 0; r < 16; ++r) { const unsigned key = kq[r >> 2][r & 3], bn = key >> 10; const unsigned bit = 1u << ((r & 3) + 8 * (r >> 2));
                      g_ |= (bn > T22) ? bit : 0u;
                      if (bn == T22) {
                          if (tieq) {
                              if (key == 0x80000000u) e_ |= bit; else { g_ |= bit; (void)__hip_atomic_fetch_add((LAS unsigned*)(lds + CCNT_OFF) + r32, 1u, __ATOMIC_RELAXED, __HIP_MEMORY_SCOPE_WORKGROUP); } }
                          else { const unsigned slot = __hip_atomic_fetch_add((LAS unsigned*)(lds + CCNT_OFF) + r32, 1u, __ATOMIC_RELAXED, __HIP_MEMORY_SCOPE_WORKGROUP);
                              if (slot < 16u) *(LAS u32x2*)(lds + CAND_OFF + (r32 * 16 + slot) * 8) = (u32x2){key, (unsigned)(64 * t + 32 * sh + (r & 3) + 8 * (r >> 2) + 4 * hi)}; } } }
                  if (sh == 0) { gm0 = g_; em0 = e_; }
                  else { unsigned glo = gm0 << (4 * hi), ghi = g_ << (4 * hi), elo = em0 << (4 * hi), ehi = e_ << (4 * hi);
                      glo |= __shfl_xor(glo, 32); ghi |= __shfl_xor(ghi, 32); elo |= __shfl_xor(elo, 32); ehi |= __shfl_xor(ehi, 32);
                      if (hi == 0) { *(LAS u32x2*)(lds + GT_OFF + (r32 * 64 + t) * 8) = (u32x2){glo, ghi}; *(LAS u32x2*)(lds + EQ_OFF + (r32 * 64 + t) * 8) = (u32x2){elo, ehi}; } }
#pragma unroll
                  for (int r4 = 0; r4 < 4; ++r4) kq[r4] = kqn[r4];
              } }
            AT_BAR();
            { int tid = tid_in; asm volatile("" : "+v"(tid)); const int q = tid >> 4, j = tid & 15;
              const unsigned c0w = MISC[192 + q], need = MISC[129 + 2 * q]; const bool tq = (c0w >> 16) != 0u; const unsigned c0 = tq ? 0u : c0w;
              if (tq && j == 0) { const unsigned cp_ = ((const LAS unsigned*)(lds + CCNT_OFF))[q]; if (cp_ > need) MISC[249] = 1u; else MISC[192 + q] = 0x10000u | (need - cp_); }
              if ((unsigned)j < c0) { const u32x2 my = *(const LAS u32x2*)(lds + CAND_OFF + (q * 16 + j) * 8); unsigned rank = 0;
#pragma unroll 1
                  for (unsigned i = 0; i < c0; ++i) { const u32x2 ot = *(const LAS u32x2*)(lds + CAND_OFF + (q * 16 + i) * 8); rank += (ot.x > my.x || (ot.x == my.x && ot.y < my.y)) ? 1u : 0u; }
                  if (rank < need) (void)__hip_atomic_fetch_or((LAS unsigned*)(lds + GT_OFF + (q * 64 + (my.y >> 6)) * 8 + 4 * ((my.y >> 5) & 1u)), 1u << (my.y & 31u), __ATOMIC_RELAXED, __HIP_MEMORY_SCOPE_WORKGROUP); } }
            AT_BAR();
                if (MISC[249] != 0u) fast = false;
            }
        }
#undef BM_SCAN
        PT_BEGIN(9)
        { int tid = tid_in; asm volatile("" : "+v"(tid)); const int q = tid >> 4, j = tid & 15; const unsigned need_eq = fast ? (((MISC[192 + q] >> 16) != 0u) ? (MISC[192 + q] & 0xffffu) : 0u) : MISC[129 + 2 * q];
          unsigned long long g[4], e[4]; unsigned ce = 0;
#pragma unroll
          for (int i = 0; i < 4; ++i) { const int t = 4 * j + i; g[i] = 0ull; e[i] = 0ull;
              if (t < ntile) { const u32x2 a = *(const LAS u32x2*)(lds + GT_OFF + (q * 64 + t) * 8), c = *(const LAS u32x2*)(lds + EQ_OFF + (q * 64 + t) * 8);
                  g[i] = ((unsigned long long)a.y << 32) | a.x; e[i] = ((unsigned long long)c.y << 32) | c.x; }
              ce += (unsigned)__builtin_popcountll(e[i]); }
          unsigned cum = ce;
#pragma unroll
          for (int off = 1; off < 16; off <<= 1) { const unsigned tt = __shfl_up(cum, off, 16); if (j >= off) cum += tt; }
          int allowed = (int)need_eq - (int)(cum - ce);
          unsigned cs = 0;
#pragma unroll
          for (int i = 0; i < 4; ++i) { unsigned long long x = e[i]; const int pc = __builtin_popcountll(x);
              if (allowed <= 0) x = 0ull; else if (pc > allowed) { int drop = pc - allowed; while (drop > 0) { x &= ~(1ull << (63 - __builtin_clzll(x))); --drop; } }
              allowed -= pc; g[i] |= x; cs += (unsigned)__builtin_popcountll(g[i]); }
          unsigned cum2 = cs;
#pragma unroll
          for (int off = 1; off < 16; off <<= 1) { const unsigned tt = __shfl_up(cum2, off, 16); if (j >= off) cum2 += tt; }
          unsigned pos = cum2 - cs;
          LAS unsigned short* sq = sel + q * 256;
#pragma unroll
          for (int i = 0; i < 4; ++i) { unsigned long long x = g[i]; const int t = 4 * j + i;
              while (x) { const int bpos = __builtin_ctzll(x); x &= x - 1; if (pos < 256u) sq[pos] = (unsigned short)(64 * t + bpos); ++pos; } } }
        PT_END(9)
    } else {
        for (int i = tid_in; i < 32 * 256; i += NWAVES * 64) { const int k = i & 255; sel[i] = (unsigned short)(k < nk ? k : 0); }
    }
    AT_BAR();
    PT_END(5)
    PT_BEGIN(4)
    int lane = lane_in; asm volatile("" : "+v"(lane));
    const int c = lane & 15, g = lane >> 4;
    const LAS bf16_t* tabB = (const LAS bf16_t*)(lds + TAB_OFF);
    const unsigned lds0 = (unsigned)(uintptr_t)lds;
    LAS unsigned char* vimg = lds + VIMG_OFF + wave * 12288;
    const unsigned vdst = (unsigned)__builtin_amdgcn_readfirstlane(lds0 + VIMG_OFF + wave * 12288);
    const bf16_t* kvb = PROJ + rowbase * AB_INP + 2048;
    const LAS unsigned short* selw = sel + (4 * wave) * 256;
#define BM_KLOAD(dst, s_) do { const int e_ = 32 * (s_) + c; const int k0_ = selw[e_], k1_ = selw[e_ + 16]; \
        const bf16_t* p0_ = kvb + (size_t)k0_ * AB_INP + 8 * g; const bf16_t* p1_ = kvb + (size_t)k1_ * AB_INP + 8 * g; \
        dst[0] = *(const GAS bf16x8*)p0_; dst[1] = *(const GAS bf16x8*)(p0_ + 32); dst[2] = *(const GAS bf16x8*)p1_; dst[3] = *(const GAS bf16x8*)(p1_ + 32); } while (0)
#define BM_VDMA(s_) do { _Pragma("unroll") for (int n_ = 0; n_ < 4; ++n_) { const int kidx_ = selw[32 * (s_) + 8 * n_ + (lane >> 3)]; \
        glds16(kvb + (size_t)kidx_ * AB_INP + 64 + 8 * (lane & 7), vdst + ((s_) % 3) * 4096 + n_ * 1024); } } while (0)
    bf16x8 kr[4][4];
    BM_KLOAD(kr[0], 0); BM_KLOAD(kr[1], 1); BM_KLOAD(kr[2], 2); BM_KLOAD(kr[3], 3);
    BM_VDMA(0); BM_VDMA(1);
    bf16x8 qb0 = (bf16x8){}, qb1 = (bf16x8){};
    float mh = 0.f, l = 0.f;
    f32x4 o[4] = {(f32x4){0.f, 0.f, 0.f, 0.f}, (f32x4){0.f, 0.f, 0.f, 0.f}, (f32x4){0.f, 0.f, 0.f, 0.f}, (f32x4){0.f, 0.f, 0.f, 0.f}};
#pragma unroll 1
    for (int s0 = 0; s0 < 32; s0 += 4) {
#pragma unroll
        for (int u = 0; u < 4; ++u) {
            const int s = s0 + u, qi = s >> 3, ch = s & 7, q = q0 + 4 * wave + qi;
            const bool first = (ch == 0);
            if (first) {
                qb0 = (bf16x8){}; qb1 = (bf16x8){};
                if (c < 8) { const bf16_t* qp = PROJ + (rowbase + q) * AB_INP + 1536 + c * 64 + 8 * g; qb0 = *(const GAS bf16x8*)qp; qb1 = *(const GAS bf16x8*)(qp + 32); }
                mh = 0.f; l = 0.f;
#pragma unroll
                for (int nt = 0; nt < 4; ++nt) o[nt] = (f32x4){0.f, 0.f, 0.f, 0.f};
            }
            if (s + 2 < 32) BM_VDMA(s + 2);
            f32x4 sa = (f32x4){0.f, 0.f, 0.f, 0.f}, sb = (f32x4){0.f, 0.f, 0.f, 0.f};
            sa = __builtin_amdgcn_mfma_f32_16x16x32_bf16(kr[u][0], qb0, sa, 0, 0, 0); sa = __builtin_amdgcn_mfma_f32_16x16x32_bf16(kr[u][1], qb1, sa, 0, 0, 0);
            sb = __builtin_amdgcn_mfma_f32_16x16x32_bf16(kr[u][2], qb0, sb, 0, 0, 0); sb = __builtin_amdgcn_mfma_f32_16x16x32_bf16(kr[u][3], qb1, sb, 0, 0, 0);
            if (s + 4 < 32) BM_KLOAD(kr[u], s + 4);
            const u32x2 wa = *(const LAS u32x2*)(selw + 32 * s + 4 * g), wb = *(const LAS u32x2*)(selw + 32 * s + 16 + 4 * g);
            const int ka[4] = {(int)(wa.x & 0xffffu), (int)(wa.x >> 16), (int)(wa.y & 0xffffu), (int)(wa.y >> 16)}, kb4[4] = {(int)(wb.x & 0xffffu), (int)(wb.x >> 16), (int)(wb.y & 0xffffu), (int)(wb.y >> 16)};
            float lm = -1e30f;
#pragma unroll
            for (int i = 0; i < 4; ++i) {
                int da = q - ka[i]; da = da > 559 ? 559 : da; int db = q - kb4[i]; db = db > 559 ? 559 : db;
                const float va = (32 * ch + 4 * g + i < ns) ? sa[i] + bf2f(tabB[(da + 63) * 8 + (c & 7)]) - mh : -1e30f;
                const float vb2 = (32 * ch + 16 + 4 * g + i < ns) ? sb[i] + bf2f(tabB[(db + 63) * 8 + (c & 7)]) - mh : -1e30f;
                sa[i] = va; sb[i] = vb2; lm = fmaxf(lm, fmaxf(va, vb2)); }
            if (first || __any(lm > 8.f)) {
                float rm = fmaxf(lm, __shfl_xor(lm, 16)); rm = fmaxf(rm, __shfl_xor(rm, 32));
                const float dl = first ? rm : fmaxf(rm, 0.f);
                mh += dl;
#pragma unroll
                for (int i = 0; i < 4; ++i) { sa[i] -= dl; sb[i] -= dl; }
                if (!first) { const float f = __builtin_amdgcn_exp2f(-dl); l *= f;
#pragma unroll
                    for (int i = 0; i < 4; ++i) { const float fi = __shfl(f, 4 * g + i);
#pragma unroll
                        for (int nt = 0; nt < 4; ++nt) o[nt][i] *= fi; } }
            }
#pragma unroll
            for (int i = 0; i < 4; ++i) { sa[i] = __builtin_amdgcn_exp2f(sa[i]); sb[i] = __builtin_amdgcn_exp2f(sb[i]); l += sa[i] + sb[i]; }
            const u32x4 pw = (u32x4){cvtpk(sa[0], sa[1]), cvtpk(sa[2], sa[3]), cvtpk(sb[0], sb[1]), cvtpk(sb[2], sb[3])};
            if (s0 != 28 || u == 0) asm volatile("s_waitcnt vmcnt(16)" ::: "memory");
            else if (u == 1) asm volatile("s_waitcnt vmcnt(12)" ::: "memory");
            else if (u == 2) asm volatile("s_waitcnt vmcnt(4)" ::: "memory");
            else asm volatile("s_waitcnt vmcnt(0)" ::: "memory");
            lds_cptr vb = (lds_cptr)vimg + (s % 3) * 4096 + (4 * g + (c >> 2)) * 128 + 8 * (c & 3);
#pragma unroll
            for (int nt = 0; nt < 4; ++nt) { const s16x4 lo = vtr(vb + 32 * nt), hi4 = vtr(vb + 16 * 128 + 32 * nt);
                const bf16x8 vf = (bf16x8){lo[0], lo[1], lo[2], lo[3], hi4[0], hi4[1], hi4[2], hi4[3]};
                o[nt] = __builtin_amdgcn_mfma_f32_16x16x32_bf16(__builtin_bit_cast(bf16x8, pw), vf, o[nt], 0, 0, 0); }
            LDS_WAIT();
            if (ch == 7) {
                float lt = l + __shfl_xor(l, 16); lt += __shfl_xor(lt, 32);
                const float linv = __builtin_amdgcn_rcpf(lt);
                if (g < 2) { bf16_t* op = ATT + (rowbase + q) * D + 512 + c;
#pragma unroll
                    for (int i = 0; i < 4; ++i) { const float li = __shfl(linv, 4 * g + i);
#pragma unroll
                        for (int nt = 0; nt < 4; ++nt) op[(4 * g + i) * 64 + 16 * nt] = (bf16_t)f2bf(o[nt][i] * li); } }
            }
        }
    }
    asm volatile("s_waitcnt vmcnt(0)" ::: "memory");
    PT_END(4)
#undef BM_KLOAD
#undef BM_VDMA
}
}
__device__ __forceinline__ void attn_b_phase(LAS unsigned char* lds, volatile LAS unsigned* MISC, const bf16_t* PROJ, const float* t5, bf16_t* ATT, unsigned* kc, int vcu, int G, int wave, int lane, int tid) {
    AT_BAR();
    { LAS bf16_t* tab = (LAS bf16_t*)(lds + TAB_OFF);
      for (int i = tid; i < 640 * 8; i += NWAVES * 64) { const int idx = i >> 3, h = i & 7; const int d = idx - 63; tab[i] = (bf16_t)f2bf(t5[t5_bucket(-d) * 12 + 4 + h] * LOG2E); } }
    AT_BAR();
    for (int p = vcu; p < 512; p += G) {
        const int b = p >> 6, s = p & 63;
#pragma unroll 1
        for (int k = 0; k < 2; ++k) bm::unit(lds, MISC, PROJ, ATT, kc, b, k ? 127 - s : s, wave, lane, tid);
    }
}
#ifndef NAIVE_B
#define NAIVE_B 0
#endif
#ifndef XBAR
#define XBAR 0
#endif
#ifndef BGCONV
#define BGCONV 1
#endif
#ifndef DUP
#define DUP 0
#endif
struct Args { const float* in[19]; float* out; unsigned char* ws; int ph_lo, ph_hi, li, pad; };
static_assert(sizeof(Args) == 19 * 8 + 8 + 8 + 16, "Args has no padding");

__global__ void __launch_bounds__(NWAVES * 64, 2) mk_fwd(Args args) {
    extern __shared__ __attribute__((aligned(16))) unsigned char lds_raw[];
    LAS unsigned char* lds = (LAS unsigned char*)lds_raw;
    volatile LAS unsigned* MISC = (volatile LAS unsigned*)(lds + MISC_OFF);
    const int tid = threadIdx.x, lane = tid & 63, wave = __builtin_amdgcn_readfirstlane(tid >> 6);
    const int G = gridDim.x; const int bx = blockIdx.x;
    const int vcu = (G % 8 == 0) ? (bx % 8) * (G / 8) + bx / 8 : bx;
    unsigned char* ws = args.ws;
    unsigned* ctl = (unsigned*)(ws + WS_CTL);
    const float* x = args.in[0]; const float* t5 = args.in[1]; const float* ln_mix = args.in[2]; const float* ln_ffn = args.in[3]; const float* ln_final = args.in[4];
    const float* ab_w_in = args.in[5]; const float* ab_w_out = args.in[6]; const float* dlam = args.in[7]; const float* subln = args.in[8];
    const float* c_w_in = args.in[9]; const float* c_w_out = args.in[10]; const float* c_rel = args.in[11];
    const float* w_rg = args.in[12]; const float* b_rg = args.in[13]; const float* w_re = args.in[14]; const float* b_re = args.in[15];
    const float* w_gate = args.in[16]; const float* w_up = args.in[17]; const float* w_down = args.in[18];
    float* hbuf = args.out;
    bf16_t* WIN0 = (bf16_t*)(ws + WS_WIN0); bf16_t* WOUT0 = (bf16_t*)(ws + WS_WOUT0); bf16_t* WCIN = (bf16_t*)(ws + WS_WCIN); bf16_t* WCOUT = (bf16_t*)(ws + WS_WCOUT);
    bf16_t* WGU = (bf16_t*)(ws + WS_WGU); bf16_t* WD = (bf16_t*)(ws + WS_WD); bf16_t* RW = (bf16_t*)(ws + WS_RW);
    bf16_t* XN = (bf16_t*)(ws + WS_XN); bf16_t* BIG = (bf16_t*)(ws + WS_BIG); bf16_t* HB = (bf16_t*)(ws + WS_H); bf16_t* Y0 = (bf16_t*)(ws + WS_Y0); bf16_t* Y1 = (bf16_t*)(ws + WS_Y1);
    float* SSQ = (float*)(ws + WS_SSQ); int* LIST = (int*)(ws + WS_LIST); float* LW = (float*)(ws + WS_LIST + 4 * MiB);

    for (int u = tid; u < 256; u += NWAVES * 64) MISC[u] = 0u;
    __syncthreads();
    const int lo = args.ph_lo, hi = args.ph_hi;
    XcdBarrier bar; bar.bar = ctl + CW_BAR + args.li * XCD_BAR_WORDS; bar.x = 0; bar.st = nullptr;
    if (hi - lo > 1) bar = xcd_barrier_post(ctl + CW_BAR + args.li * XCD_BAR_WORDS, MISC);
#define IN(k) (lo <= (k) && (k) < hi)
#define SEAM(k) do { if (IN(k) && IN((k) + 1)) { unsigned long long ptb_ = 0; if (PROBE_T == 80) ptb_ = __builtin_amdgcn_s_memrealtime(); xcd_barrier(bar); if (PROBE_T == 80 && threadIdx.x == 0) MISC[240] += (unsigned)(__builtin_amdgcn_s_memrealtime() - ptb_); for (int xb_ = 0; xb_ < XBAR; ++xb_) xcd_barrier(bar); } } while (0)
    const int gw = vcu * NWAVES + wave, NGW = G * NWAVES;


#define MOE_TILES(l) do { __syncthreads(); if (tid < NEXP) MISC[64 + tid] = __hip_atomic_load(ctl + CW_CNT + (l) * 32 + tid, __ATOMIC_RELAXED, __HIP_MEMORY_SCOPE_AGENT); __syncthreads(); \
        if (tid == 0) { int a_ = 0; for (int e_ = 0; e_ < NEXP; ++e_) { MISC[16 + e_] = (unsigned)a_; a_ += ((int)MISC[64 + e_] + 255) >> 8; } MISC[16 + NEXP] = (unsigned)a_; } __syncthreads(); } while (0)
#define MOE_LAYER(l, P) \
    if (IN(P)) { router_phase(lds, MISC, hbuf, SSQ, ln_ffn + (l) * D, RW + (size_t)(l) * 2 * 48 * D, b_rg + (l) * 4, b_re + (l) * 32, XN, ctl + CW_CNT + (l) * 32, LIST, LW, vcu, G, wave, lane, tid); } \
    PT_ENDX(20 + (P)) SEAM(P); PT_BEGINX(21 + (P)) \
    if (IN((P) + 1)) { MOE_TILES(l); \
        pg8::MoeOrder<true> S{(const LAS int*)(lds + MISC_OFF + 64), (const LAS int*)(lds + MISC_OFF + 256), G, bx, 4, (int)MISC[16 + NEXP], 0u, (size_t)1024 * D * 2, (size_t)256 * D * 2, ((DUP & 16) && (l) == 0) ? 2 : 1}; \
        pg8::Gemm g{XN, WGU + (size_t)(l) * NEXP * 1024 * D, D, D, D, LIST}; pg8::EpiSwiglu E{HB}; \
        pg8::gemm_phase<pg8::EpiSwiglu, pg8::MoeOrder<true>>(lds + RING_OFF, g, S, E); } \
    PT_ENDX(21 + (P)) SEAM((P) + 1); PT_BEGINX(22 + (P)) \
    if (IN((P) + 2)) { MOE_TILES(l); \
        pg8::MoeOrder<false> S{(const LAS int*)(lds + MISC_OFF + 64), (const LAS int*)(lds + MISC_OFF + 256), G, bx, 4, (int)MISC[16 + NEXP], (unsigned)(256 * DEXP * 2), (size_t)D * DEXP * 2, (size_t)256 * DEXP * 2, ((DUP & 32) && (l) == 0) ? 2 : 1}; \
        pg8::Gemm g{HB, WD + (size_t)(l) * NEXP * D * DEXP, DEXP, DEXP, DEXP, nullptr}; pg8::EpiScatter E{Y0, Y1, LIST, LW}; \
        pg8::gemm_phase<pg8::EpiScatter, pg8::MoeOrder<false>>(lds + RING_OFF, g, S, E); } \
    PT_ENDX(22 + (P)) SEAM((P) + 2); PT_BEGINX(23 + (P))

    unsigned long long ptx_ = 0;
    PT_BEGINX(20)
    if (IN(0)) for (int rep = 0; rep < ((DUP & 1) ? 2 : 1); ++rep) {
        LAS float* scr = (LAS float*)(lds + RING_OFF + wave * 16384);
        constexpr int I1 = 16 * 80, I2 = 16 * 32, I3 = 16 * 96, I4 = 16 * 32, IE = 768, NITEMS = I1 + I2 + I3 + I4 + (BGCONV ? 0 : 64 * IE);
        PT_BEGIN(90)
        for (int it = gw; it < NITEMS; it += NGW) {
            int r = it;
            if (r < I1) { const int kb = r / 80, nb = r % 80, n0 = nb * 32; conv_item(ab_w_in, D, AB_IN, WIN0, kb * 64, n0, n0, (n0 < 512 || (n0 >= 1536 && n0 < 2048)) ? QSCALE : 1.f, scr, lane); continue; } r -= I1;
            if (r < I2) { const int kb = r / 32, nb = r % 32; conv_item(ab_w_out, D, D, WOUT0, kb * 64, nb * 32, nb * 32, 1.f, scr, lane); continue; } r -= I2;
            if (r < I3) { const int kb = r / 96, nb = r % 96, n0 = nb * 32; conv_item(c_w_in, D, C_IN, WCIN, kb * 64, n0, n0, n0 < 1024 ? QSCALE : 1.f, scr, lane); continue; } r -= I3;
            if (r < I4) { const int kb = r / 32, nb = r % 32; conv_item(c_w_out, D, D, WCOUT, kb * 64, nb * 32, nb * 32, 1.f, scr, lane); continue; } r -= I4;
            const int le = r / IE; r -= le * IE;
            if (r < 512) { const int up = r >> 8, q = r & 255, kb = q / 16, nb = q % 16, n0 = nb * 32;
                conv_item((up ? w_up : w_gate) + (size_t)le * D * DEXP, D, DEXP, WGU + (size_t)le * 1024 * D, kb * 64, n0, 256 * (n0 >> 7) + 128 * up + (n0 & 127), 1.f, scr, lane); }
            else { const int q = r - 512, kb = q / 32, nb = q % 32; conv_item(w_down + (size_t)le * DEXP * D, DEXP, D, WD + (size_t)le * D * DEXP, kb * 64, nb * 32, nb * 32, 1.f, scr, lane); }
        }
        PT_END(90)
        for (int i = (vcu * NWAVES * 64 + tid); i < 2 * 48 * D; i += G * NWAVES * 64) {
            const int l = i / (48 * D), e = (i / D) % 48, k = i % D;
            float v = 0.f; if (e < 4) v = w_rg[(size_t)l * D * 4 + k * 4 + e]; else if (e < 36) v = w_re[(size_t)l * D * 32 + k * 32 + (e - 4)];
            const unsigned hb = f2bf(v); const float lof = v - __uint_as_float(hb << 16);
            RW[((size_t)(l * 2 + 0) * 48 + e) * D + k] = (bf16_t)hb; RW[((size_t)(l * 2 + 1) * 48 + e) * D + k] = (bf16_t)f2bf(lof);
        }
        if (bx == 0 && wave == 0) { const float a = wave_sum(dlam[lane] * dlam[64 + lane]), b = wave_sum(dlam[128 + lane] * dlam[192 + lane]); if (lane == 0) ((float*)ctl)[CW_LAM] = __expf(a) - __expf(b) + 0.2f; }
        RowIO io{x, nullptr, nullptr, ln_mix, XN, nullptr};
        PT_BEGIN(92)
        for (int m = gw; m < NTOK; m += 2 * NGW) rms_row2<false, true, false, false>(io, m, m + NGW, lane);
        PT_END(92)
    }
    PT_ENDX(20)
    SEAM(0);
    PT_BEGINX(21)
    if (IN(1)) {
        pg8::Gemm g{XN, WIN0, D, D, D, nullptr}; pg8::DenseOrder S; S.init(NTOK, AB_INP, G, bx, D, D, (DUP & 2) ? 2 : 1);
        pg8::EpiBf16 E{BIG, AB_INP};
        pg8::gemm_phase<pg8::EpiBf16, pg8::DenseOrder>(lds + RING_OFF, g, S, E);
    }
    PT_ENDX(21)
    SEAM(1);
    PT_BEGINX(22)
    if (IN(2)) {
        const float lamv = __hip_atomic_load((float*)ctl + CW_LAM, __ATOMIC_RELAXED, __HIP_MEMORY_SCOPE_AGENT);
        BgConv bg{w_gate, w_up, w_down, WGU, WD, G, bx, BGCONV ? 0 : (1 << 20), 0, (unsigned)(wave < 7 ? 100352 + wave * 4096 : TAB_OFF + 12288)};
        for (int rep = 0; rep < ((DUP & 4) ? 2 : 1); ++rep) attn_a_phase(lds, BIG, t5, subln, lamv, XN, vcu, G, wave, lane, tid, bg);
        if (!NAIVE_B) for (int rep = 0; rep < ((DUP & 8) ? 2 : 1); ++rep) attn_b_phase(lds, MISC, BIG, t5, XN, (unsigned*)hbuf + (size_t)bx * 131072, vcu, G, wave, lane, tid);
    }
    PT_ENDX(22)
    SEAM(2);
    PT_BEGINX(23)
    if (IN(3)) {
        pg8::Gemm g{XN, WOUT0, D, D, D, nullptr}; pg8::DenseOrder S; S.init(NTOK, D, G, bx, D, D, (DUP & 256) ? 2 : 1);
        pg8::EpiResid<false> E{x, hbuf, nullptr, nullptr, SSQ};
        pg8::gemm_phase<pg8::EpiResid<false>, pg8::DenseOrder, true>(lds + RING_OFF, g, S, E);
    }
    PT_ENDX(23)
    SEAM(3);
    PT_BEGINX(24)
    MOE_LAYER(0, 4)
    if (IN(7)) {
        RowIO io{hbuf, Y0, Y1, ln_mix + D, XN, hbuf};
        for (int m = gw; m < NTOK; m += 2 * NGW) rms_row2<true, true, true, false>(io, m, m + NGW, lane);
    }
    PT_ENDX(27)
    SEAM(7);
    PT_BEGINX(28)
    if (IN(8)) {
        pg8::Gemm g{XN, WCIN, D, D, D, nullptr}; pg8::DenseOrder S; S.init(NTOK, C_IN, G, bx, D, D, (DUP & 64) ? 2 : 1);
        pg8::EpiBf16 E{BIG, C_IN};
        pg8::gemm_phase<pg8::EpiBf16, pg8::DenseOrder>(lds + RING_OFF, g, S, E);
    }
    PT_ENDX(28)
    SEAM(8);
    PT_BEGINX(29)
    if (IN(9)) for (int rep = 0; rep < ((DUP & 128) ? 2 : 1); ++rep) attn_c_phase(lds, BIG, c_rel, XN, vcu, G, wave, lane, tid);
    PT_ENDX(29)
    SEAM(9);
    PT_BEGINX(30)
    if (IN(10)) {
        pg8::Gemm g{XN, WCOUT, D, D, D, nullptr}; pg8::DenseOrder S; S.init(NTOK, D, G, bx, D, D);
        pg8::EpiResid<false> E{hbuf, hbuf, nullptr, nullptr, SSQ};
        pg8::gemm_phase<pg8::EpiResid<false>, pg8::DenseOrder, true>(lds + RING_OFF, g, S, E);
    }
    PT_ENDX(30)
    SEAM(10);
    PT_BEGINX(31)
    MOE_LAYER(1, 11)
    if (IN(14)) {
        if (DUP & 512) { RowIO iod{hbuf, Y0, Y1, ln_final, nullptr, (float*)XN}; for (int m = gw; m < NTOK; m += 2 * NGW) rms_row2<true, false, false, true>(iod, m, m + NGW, lane); }
        RowIO io{hbuf, Y0, Y1, ln_final, nullptr, hbuf};
        for (int m = gw; m < NTOK; m += 2 * NGW) rms_row2<true, false, false, true>(io, m, m + NGW, lane);
    }
    PT_ENDX(34)
    if (PROBE_T) { __syncthreads(); const unsigned long long te = __builtin_amdgcn_s_memrealtime(); const unsigned long long w = 4ull * MISC[240]; while (__builtin_amdgcn_s_memrealtime() - te < w) __builtin_amdgcn_s_sleep(8); }
#undef IN
#undef SEAM
}

#ifndef OPT_MASK
#define OPT_MASK 0x7FFF
#endif
extern "C" void kernel_launch(void* const* d_in, const int* in_sizes, int n_in, void* d_out, int out_size, void* d_ws, size_t ws_size, hipStream_t stream) {
    static int grid = 0;
    if (grid == 0) {
        if (n_in != 19 || ws_size < WS_END) { fprintf(stderr, "kernel_launch: unexpected n_in %d or ws_size %zu (< %zu)\n", n_in, ws_size, (size_t)WS_END); grid = -1; return; }
        int dev = 0, cus = 0, per_cu = 0;
        if (hipGetDevice(&dev) != hipSuccess || hipDeviceGetAttribute(&cus, hipDeviceAttributeMultiprocessorCount, dev) != hipSuccess) { grid = -1; return; }
        if (hipFuncSetAttribute((const void*)mk_fwd, hipFuncAttributeMaxDynamicSharedMemorySize, LDS_BYTES) != hipSuccess) { fprintf(stderr, "kernel_launch: hipFuncSetAttribute failed\n"); grid = -1; return; }
        if (hipOccupancyMaxActiveBlocksPerMultiprocessor(&per_cu, (const void*)mk_fwd, NWAVES * 64, LDS_BYTES) != hipSuccess || per_cu < 1) fprintf(stderr, "kernel_launch: occupancy query says %d\n", per_cu);
        (void)hipGetLastError();
        grid = cus;
    }
    if (grid < 0) return;
    const float* x = (const float*)d_in[0]; const float* t5 = (const float*)d_in[1]; const float* ln_mix = (const float*)d_in[2]; const float* ln_ffn = (const float*)d_in[3];
    const float* ln_final = (const float*)d_in[4]; const float* ab_w_in = (const float*)d_in[5]; const float* ab_w_out = (const float*)d_in[6]; const float* dlam = (const float*)d_in[7];
    const float* subln = (const float*)d_in[8]; const float* c_w_in = (const float*)d_in[9]; const float* c_w_out = (const float*)d_in[10]; const float* c_rel = (const float*)d_in[11];
    const float* w_rg = (const float*)d_in[12]; const float* b_rg = (const float*)d_in[13]; const float* w_re = (const float*)d_in[14]; const float* b_re = (const float*)d_in[15];
    const float* w_gate = (const float*)d_in[16]; const float* w_up = (const float*)d_in[17]; const float* w_down = (const float*)d_in[18];
    float* hbuf = (float*)d_out; unsigned char* ws = (unsigned char*)d_ws;
    unsigned* ctl = (unsigned*)(ws + WS_CTL);
    bf16_t* XN = (bf16_t*)(ws + WS_XN); bf16_t* BIG = (bf16_t*)(ws + WS_BIG); bf16_t* HB = (bf16_t*)(ws + WS_H); bf16_t* Y0 = (bf16_t*)(ws + WS_Y0); bf16_t* Y1 = (bf16_t*)(ws + WS_Y1);
    float* SSQ = (float*)(ws + WS_SSQ); int* LIST = (int*)(ws + WS_LIST); float* LW = (float*)(ws + WS_LIST + 4 * MiB);
    (void)hipMemsetAsync(ws + WS_CTL, 0, CTL_ZERO_BYTES, stream);
    Args a{};
    for (int i = 0; i < 19; ++i) a.in[i] = (const float*)d_in[i];
    a.out = hbuf; a.ws = ws;
    int li = 0;
    for (int p = 0; p < NPHASE;) {
        if ((OPT_MASK >> p) & 1) {
            int q = p; while (q < NPHASE && ((OPT_MASK >> q) & 1)) { ++q; if (NAIVE_B && q == 3) break; }
            a.ph_lo = p; a.ph_hi = q; a.li = li++;
            hipLaunchKernelGGL(mk_fwd, dim3(grid), dim3(NWAVES * 64), LDS_BYTES, stream, a);
            p = q; continue;
        }
        ++p;
    }
}
```
